# Optimizing an MI355X kernel written in HIP

```python
import jax, jax.numpy as jnp
from jax import lax
import numpy as np

D_MODEL = 1024
BATCH = 2
SEQ = 8192
DEPTH = 1

GRID_W = 64
D_MIX = D_MODEL
ATTN_WIDTH = D_MIX // 2
REC_WIDTH = D_MIX - ATTN_WIDTH
HEAD_DIM = 128
N_Q_HEADS = ATTN_WIDTH // HEAD_DIM
N_KV_HEADS = 2
KV_GROUPS = N_Q_HEADS // N_KV_HEADS
ROPE_THETA = 10000.0
ROPE_AXIS_DIM = HEAD_DIM // 2
Q_BLOCK = 128
REC_HEAD_DIM = 128
N_REC_HEADS = REC_WIDTH // REC_HEAD_DIM
REC_CHUNK = 64
D_FF = 2816
EPS = 1e-6
IN_SPLITS = (N_Q_HEADS * HEAD_DIM,
             N_KV_HEADS * HEAD_DIM,
             N_KV_HEADS * HEAD_DIM,
             REC_WIDTH,
             REC_WIDTH,
             REC_WIDTH,
             REC_WIDTH,
             REC_WIDTH)
D_IN_MIX = 512 + 256 + 256 + 5 * 512

kernel_name = "hybrid_gqa_hgrn2_macaron_encoder"


def rms_norm(x, gain):
    xf = x.astype(jnp.float32)
    y = xf * lax.rsqrt(jnp.mean(xf * xf, axis=-1, keepdims=True) + EPS)
    return (y * gain.astype(jnp.float32)).astype(x.dtype)


def swiglu_half_step(x, gain, w_in, w_out):
    h = rms_norm(x, gain)
    gate, up = jnp.split(h @ w_in, 2, axis=-1)
    return (jax.nn.silu(gate) * up) @ w_out


def axial_rope_tables(seq_len):
    rows = seq_len // GRID_W
    row_ids = jnp.repeat(jnp.arange(rows, dtype=jnp.float32), GRID_W)
    col_ids = jnp.tile(jnp.arange(GRID_W, dtype=jnp.float32), rows)
    inv_freq = ROPE_THETA ** (-jnp.arange(0, ROPE_AXIS_DIM, 2, dtype=jnp.float32) / ROPE_AXIS_DIM)
    ang_r = row_ids[:, None] * inv_freq[None, :]
    ang_c = col_ids[:, None] * inv_freq[None, :]
    return jnp.cos(ang_r), jnp.sin(ang_r), jnp.cos(ang_c), jnp.sin(ang_c)


def _rotate(xp, cos, sin):
    x1, x2 = jnp.split(xp, 2, axis=-1)
    return jnp.concatenate([x1 * cos - x2 * sin, x2 * cos + x1 * sin], axis=-1)


def apply_axial_rope(x, tables):
    cos_r, sin_r, cos_c, sin_c = (t[:, None, :] for t in tables)
    xf = x.astype(jnp.float32)
    out = jnp.concatenate([_rotate(xf[..., :ROPE_AXIS_DIM], cos_r, sin_r),
                           _rotate(xf[..., ROPE_AXIS_DIM:], cos_c, sin_c)], axis=-1)
    return out.astype(x.dtype)


def gqa_bidirectional(q, k, v, q_gain, k_gain):
    bsz, seq_len = q.shape[0], q.shape[1]
    tables = axial_rope_tables(seq_len)
    q = apply_axial_rope(rms_norm(q, q_gain), tables) * (HEAD_DIM ** -0.5)
    k = apply_axial_rope(rms_norm(k, k_gain), tables)
    n_blk = seq_len // Q_BLOCK
    qb = q.reshape(bsz, n_blk, Q_BLOCK, N_KV_HEADS, KV_GROUPS, HEAD_DIM)
    qb = jnp.moveaxis(qb, 1, 0)

    def one_block(q_blk):
        s = jnp.einsum('bqkgd,bskd->bkgqs', q_blk, k).astype(jnp.float32)
        p = jax.nn.softmax(s, axis=-1).astype(v.dtype)
        return jnp.einsum('bkgqs,bskd->bqkgd', p, v)

    o = lax.map(one_block, qb)
    return jnp.moveaxis(o, 0, 1).reshape(bsz, seq_len, ATTN_WIDTH)


def hgrn2_chunk_scan(q, k, v, log_f):
    n, seq_len, h, dk = q.shape
    dv = v.shape[-1]
    nc = seq_len // REC_CHUNK

    def to_chunks(a):
        a = a.astype(jnp.float32).reshape(n, nc, REC_CHUNK, h, a.shape[-1])
        return jnp.transpose(a, (1, 0, 3, 2, 4))

    causal = jnp.tril(jnp.ones((REC_CHUNK, REC_CHUNK), dtype=bool))[:, :, None]

    def step(state, inp):
        qc, kc, vc, gc = inp
        b = jnp.cumsum(gc, axis=-2)
        inter = jnp.einsum('nhcd,nhde->nhce', qc * jnp.exp(b), state)
        diff = b[..., :, None, :] - b[..., None, :, :]
        decay = jnp.exp(jnp.where(causal, diff, -jnp.inf))
        scores = jnp.einsum('nhtd,nhtsd,nhsd->nhts', qc, decay, kc)
        intra = jnp.einsum('nhts,nhse->nhte', scores, vc)
        b_last = b[..., -1:, :]
        new_state = jnp.exp(b_last[..., 0, :])[..., None] * state + \
            jnp.einsum('nhsd,nhse->nhde', kc * jnp.exp(b_last - b), vc)
        return new_state, inter + intra

    s0 = jnp.zeros((n, h, dk, dv), jnp.float32)
    _, o = lax.scan(step, s0, (to_chunks(q), to_chunks(k), to_chunks(v), to_chunks(log_f)))
    o = jnp.transpose(o, (1, 0, 3, 2, 4)).reshape(n, seq_len, h, dv)
    return o.astype(v.dtype)


def hgrn2_bidirectional(q, zf_fwd, zf_bwd, i, g, lb, out_gain):
    bsz, seq_len = q.shape[0], q.shape[1]
    shp = (bsz, seq_len, N_REC_HEADS, REC_HEAD_DIM)

    def gates(z, lower):
        f = lower + (1.0 - lower) * jax.nn.sigmoid(z.astype(jnp.float32))
        return jnp.log(f).reshape(shp), (1.0 - f).reshape(shp)

    logf_fwd, k_fwd = gates(zf_fwd, lb[0])
    logf_bwd, k_bwd = gates(zf_bwd, lb[1])
    q4, i4 = q.reshape(shp), i.reshape(shp)
    flip = lambda a: jnp.flip(a, axis=1)
    q_dir = jnp.concatenate([q4, flip(q4)], axis=0)
    k_dir = jnp.concatenate([k_fwd, flip(k_bwd)], axis=0)
    v_dir = jnp.concatenate([i4, flip(i4)], axis=0)
    g_dir = jnp.concatenate([logf_fwd, flip(logf_bwd)], axis=0)
    o_dir = hgrn2_chunk_scan(q_dir, k_dir, v_dir, g_dir)
    o = o_dir[:bsz] + flip(o_dir[bsz:])
    o = rms_norm(o, out_gain).reshape(bsz, seq_len, REC_WIDTH)
    return o * jax.nn.silu(g)


def hybrid_mixer(x, layer, norm_gain, w_in, q_gain, k_gain, attn_out_gain, rec_lb_logits,
                 rec_out_gain, w_out):
    bsz, seq_len = x.shape[0], x.shape[1]
    h = rms_norm(x, norm_gain)
    proj = h @ w_in
    offsets = [int(o) for o in np.cumsum(IN_SPLITS)[:-1]]
    aq, ak, av, rq, rf_fwd, rf_bwd, ri, rg = jnp.split(proj, offsets, axis=-1)
    attn = gqa_bidirectional(aq.reshape(bsz, seq_len, N_Q_HEADS, HEAD_DIM),
                             ak.reshape(bsz, seq_len, N_KV_HEADS, HEAD_DIM),
                             av.reshape(bsz, seq_len, N_KV_HEADS, HEAD_DIM), q_gain, k_gain)
    attn = rms_norm(attn, attn_out_gain)
    lb_all = jnp.cumsum(jax.nn.softmax(rec_lb_logits.astype(jnp.float32), axis=1), axis=1)
    lb = lb_all[:, layer]
    rec = hgrn2_bidirectional(rq, rf_fwd, rf_bwd, ri, rg, lb, rec_out_gain)
    return jnp.concatenate([attn, rec.astype(attn.dtype)], axis=-1) @ w_out


def setup_inputs(seed: int = 0) -> dict:
    key = jax.random.key(seed)
    ks = jax.random.split(key, 16)
    nrm = lambda k, shape, s: jax.random.normal(k, shape, jnp.float32) * s
    gain = lambda k, shape: 1.0 + 0.02 * jax.random.normal(k, shape, jnp.float32)
    return {
        "x": nrm(ks[0], (BATCH, SEQ, D_MODEL), 1.0),
        "ffn1_norm": gain(ks[1], (DEPTH, D_MODEL)),
        "ffn1_w_in": nrm(ks[2], (DEPTH, D_MODEL, 2 * D_FF), D_MODEL ** -0.5),
        "ffn1_w_out": nrm(ks[3], (DEPTH, D_FF, D_MODEL), D_FF ** -0.5),
        "mix_norm": gain(ks[4], (DEPTH, D_MODEL)),
        "w_in_mix": nrm(ks[5], (DEPTH, D_MODEL, D_IN_MIX), D_MODEL ** -0.5),
        "attn_q_norm": gain(ks[6], (DEPTH, HEAD_DIM)),
        "attn_k_norm": gain(ks[7], (DEPTH, HEAD_DIM)),
        "attn_out_norm": gain(ks[8], (DEPTH, ATTN_WIDTH)),
        "rec_lb_logits": nrm(ks[9], (2, DEPTH + 1, REC_WIDTH), 0.5),
        "rec_out_norm": gain(ks[10], (DEPTH, REC_HEAD_DIM)),
        "w_out_mix": nrm(ks[11], (DEPTH, D_MIX, D_MODEL), D_MIX ** -0.5),
        "ffn2_norm": gain(ks[12], (DEPTH, D_MODEL)),
        "ffn2_w_in": nrm(ks[13], (DEPTH, D_MODEL, 2 * D_FF), D_MODEL ** -0.5),
        "ffn2_w_out": nrm(ks[14], (DEPTH, D_FF, D_MODEL), D_FF ** -0.5),
        "final_norm": gain(ks[15], (DEPTH, D_MODEL)),
    }


def reference(x, ffn1_norm, ffn1_w_in, ffn1_w_out, mix_norm, w_in_mix, attn_q_norm, attn_k_norm,
              attn_out_norm, rec_lb_logits, rec_out_norm, w_out_mix, ffn2_norm, ffn2_w_in,
              ffn2_w_out, final_norm):
    for l in range(DEPTH):
        x = x + 0.5 * swiglu_half_step(x, ffn1_norm[l], ffn1_w_in[l], ffn1_w_out[l])
        x = x + hybrid_mixer(x, l, mix_norm[l], w_in_mix[l], attn_q_norm[l], attn_k_norm[l],
                             attn_out_norm[l], rec_lb_logits, rec_out_norm[l], w_out_mix[l])
        x = x + 0.5 * swiglu_half_step(x, ffn2_norm[l], ffn2_w_in[l], ffn2_w_out[l])
        x = rms_norm(x, final_norm[l])
    return x
```

```cpp
#include <hip/hip_runtime.h>
#include <hip/hip_bf16.h>
#include <hip/hip_cooperative_groups.h>
#include <cstdio>
#include <cstdint>
namespace cg = cooperative_groups;
#ifndef MK_LAUNCHES
#define MK_LAUNCHES 1
#endif
namespace pg8 {
#define PG8_LAS __attribute__((address_space(3)))
typedef unsigned short bf16_t;
typedef short bf16x8 __attribute__((ext_vector_type(8)));
typedef float f32x4 __attribute__((ext_vector_type(4)));
typedef unsigned u32x4 __attribute__((ext_vector_type(4)));
constexpr int BM = 256, BK = 64, HALF = 128, HTB = HALF * BK * 2  , STAGE_BYTES = 8 * HTB, NXCD = 8, WGM = 8;

__host__ __device__ __forceinline__ int lds_byte(int r, int c) { const int st = (r >> 4) * 2 + (c >> 5), rr = r & 15, cc = c & 31, ob = rr * 64 + cc * 2; return st * 1024 + (ob ^ (((ob >> 9) & 1) << 5)); }
__host__ __device__ __forceinline__ void stage_rc(int b, int& R, int& C) { const int st = b / 1024, sb = b % 1024, swz = sb ^ (((sb >> 9) & 1) << 5); R = (st >> 1) * 16 + swz / 64; C = (st & 1) * 32 + (swz % 64) / 2; }
__host__ __device__ __forceinline__ int perm32(int rho) { const int n = rho >> 4, i = rho & 15; return 8 * (i >> 2) + 4 * n + (i & 3); }

struct Unit { int pm, pn; };
struct Gemm { const bf16_t* A; const bf16_t* Bt; int M, N, K; };

struct StaticOrder {
    int nM, nN, nwg, G, c;
    __host__ __device__ void init(int M, int N, int G_, int c_) { nM = M / BM; nN = N / BM; nwg = nM * nN; G = G_; c = c_; }
    __host__ __device__ bool next(int i, Unit& u) const {
        const long L = (long)i * G + c; if (L >= nwg) return false;
        int wgid = (int)L; { const int q = nwg / NXCD, r = nwg % NXCD, xcd = wgid % NXCD, off = wgid / NXCD; wgid = (xcd < r ? xcd * (q + 1) : r * (q + 1) + (xcd - r) * q) + off; }
        const int nig = WGM * nN, gid = wgid / nig, fm = gid * WGM, gsz = (nM - fm) < WGM ? (nM - fm) : WGM;
        u.pm = fm + ((wgid % nig) % gsz); u.pn = (wgid % nig) / gsz; return true;
    }
    __device__ __forceinline__ void a_ready(const Unit&) const {}
    __device__ __forceinline__ void done(const Unit&) const {}
};

typedef __bf16 bf16x2_cv __attribute__((ext_vector_type(2)));
typedef float f32x2_cv __attribute__((ext_vector_type(2)));
__device__ __forceinline__ unsigned cvt_pk_bf16(float lo, float hi) { const bf16x2_cv v = __builtin_convertvector((f32x2_cv){lo, hi}, bf16x2_cv); return __builtin_bit_cast(unsigned, v); }
typedef float f32x2 __attribute__((ext_vector_type(2)));
__device__ __forceinline__ f32x2 gelu_pk(f32x2 v) {
    const f32x2 av = __builtin_elementwise_abs(v), d = av * 0.2316418882f + 1.0f;
    f32x2 t; t.x = __builtin_amdgcn_rcpf(d.x); t.y = __builtin_amdgcn_rcpf(d.y);
    f32x2 q = t * 0.5307027145f + (-0.7265760135f); q = q * t + 0.7107068705f; q = q * t + (-0.142248368f); q = q * t + 0.127414796f; q = q * t;
    const f32x2 s = (v * v) * (-0.72134752044f);
    f32x2 e; e.x = __builtin_amdgcn_exp2f(s.x); e.y = __builtin_amdgcn_exp2f(s.y);
    const f32x2 m = v * (q * e), r = v - m;
    f32x2 o; o.x = v.x < 0.f ? m.x : r.x; o.y = v.y < 0.f ? m.y : r.y; return o;
}

template <int ACT  > struct EpiBf16 {
    static constexpr bool PERM = true, AFTER_DRAIN = false; static_assert(ACT == 0 || ACT == 1, "EpiBf16: ACT is 0 (none) or 1 (gelu_pk)");
    bf16_t* O; int ldc; const float* bias; int split_cols; size_t split_stride; float scale0;
    __device__ __forceinline__ void operator()(const f32x4 (&acc)[2][2][4][2], const Unit& u, int wr, int wc, int fr, int fq) const {
        const int row0 = u.pm * BM + wr * 64 + fr; int colt = u.pn * BM; bf16_t* base = O;
        float sc = 1.f; if (split_cols) { const int t = colt / split_cols; base += (size_t)t * split_stride; colt -= t * split_cols; if (t == 0) sc = scale0; }
        const int col0 = colt + wc * 32 + 8 * fq, bcol0 = u.pn * BM + wc * 32 + 8 * fq;
        f32x4 bv[2][2];
#pragma unroll
        for (int bj = 0; bj < 2; ++bj)
#pragma unroll
            for (int n = 0; n < 2; ++n) bv[bj][n] = bias ? *(const f32x4*)(bias + bcol0 + bj * HALF + 4 * n) : (f32x4){0.f, 0.f, 0.f, 0.f};
#pragma unroll
        for (int ai = 0; ai < 2; ++ai)
#pragma unroll
            for (int m = 0; m < 4; ++m) { bf16_t* rowp = base + (size_t)(row0 + ai * HALF + m * 16) * ldc + col0;
#pragma unroll
                for (int bj = 0; bj < 2; ++bj) { f32x4 v0 = acc[ai][bj][m][0] + bv[bj][0], v1 = acc[ai][bj][m][1] + bv[bj][1];
                    if (ACT == 1) { f32x2 a = gelu_pk((f32x2){v0[0], v0[1]}), b = gelu_pk((f32x2){v0[2], v0[3]}), c = gelu_pk((f32x2){v1[0], v1[1]}), d = gelu_pk((f32x2){v1[2], v1[3]});
                        v0 = (f32x4){a.x, a.y, b.x, b.y}; v1 = (f32x4){c.x, c.y, d.x, d.y}; }
                    v0 = v0 * sc; v1 = v1 * sc; u32x4 w; w.x = cvt_pk_bf16(v0[0], v0[1]); w.y = cvt_pk_bf16(v0[2], v0[3]); w.z = cvt_pk_bf16(v1[0], v1[1]); w.w = cvt_pk_bf16(v1[2], v1[3]);
                    *(u32x4*)(rowp + bj * HALF) = w; } }
    }
};

struct PanelStats {
    unsigned* xbuf;
    unsigned* cnt;
    unsigned* tmo;
    int ntn; float eps;
    unsigned code;
    __device__ __forceinline__ bool run(const f32x4 (&v)[2][2][4][2], const Unit& u, int wr, int wc, int fr, int fq, PG8_LAS unsigned char* lds, int wid, int lane) const {
        typedef float f32x2v __attribute__((ext_vector_type(2)));
        PG8_LAS f32x2v* P = (PG8_LAS f32x2v*)lds;
        PG8_LAS f32x2v* S = (PG8_LAS f32x2v*)(lds + 8192);
        PG8_LAS unsigned* flag = (PG8_LAS unsigned*)(lds + 8192 + 2048);
#pragma unroll
        for (int ai = 0; ai < 2; ++ai)
#pragma unroll
            for (int m = 0; m < 4; ++m) {
                float s = 0.f;
#pragma unroll
                for (int bj = 0; bj < 2; ++bj)
#pragma unroll
                    for (int n = 0; n < 2; ++n) { const f32x4 x = v[ai][bj][m][n]; s += (x[0] + x[1]) + (x[2] + x[3]); }
                s += __shfl_xor(s, 16); s += __shfl_xor(s, 32);
                const float mw = s * (1.0f / 64.0f); float q = 0.f;
#pragma unroll
                for (int bj = 0; bj < 2; ++bj)
#pragma unroll
                    for (int n = 0; n < 2; ++n) { const f32x4 d = v[ai][bj][m][n] - mw; q += (d[0] * d[0] + d[1] * d[1]) + (d[2] * d[2] + d[3] * d[3]); }
                q += __shfl_xor(q, 16); q += __shfl_xor(q, 32);
                if (fq == 0) P[(ai * HALF + wr * 64 + m * 16 + fr) * 4 + wc] = (f32x2v){mw, q};
            }
        asm volatile("s_waitcnt lgkmcnt(0)" ::: "memory"); __builtin_amdgcn_s_barrier(); asm volatile("" ::: "memory");
#if defined(BROKEN_EXCHANGE_NO_WAIT)
#warning BROKEN CONTROL BUILD: the row-statistics exchange does not wait; results are wrong by design
        if (blockIdx.x >= 64) { const long long t0_ = clock64(); while (clock64() - t0_ < 60000) __builtin_amdgcn_s_sleep(8); }
#endif
        const int row = wid * 32 + (lane & 31);
        if (lane < 32) {
            const f32x2v a = P[row * 4 + 0], b = P[row * 4 + 1], c = P[row * 4 + 2], d = P[row * 4 + 3];
            const float mt = (a.x + b.x + c.x + d.x) * 0.25f;
            const float da = a.x - mt, db = b.x - mt, dc = c.x - mt, dd = d.x - mt;
            const float m2 = (a.y + b.y) + (c.y + d.y) + 64.0f * ((da * da + db * db) + (dc * dc + dd * dd));
            unsigned long long* slot = (unsigned long long*)xbuf + ((size_t)(u.pm * BM + row) * 4 + u.pn);
            __hip_atomic_store(slot, ((unsigned long long)__float_as_uint(m2) << 32) | __float_as_uint(mt), __ATOMIC_RELAXED, __HIP_MEMORY_SCOPE_AGENT);
        }
        asm volatile("s_waitcnt vmcnt(0)" ::: "memory");
        if (lane == 0) __hip_atomic_fetch_add(cnt + 64 * u.pm, 1u, __ATOMIC_RELAXED, __HIP_MEMORY_SCOPE_AGENT);
        if (wid == 0) {
            bool dead = false; const unsigned long long t0 = __builtin_amdgcn_s_memrealtime(); const unsigned want = 8u * (unsigned)ntn;
            for (;;) {
#if defined(BROKEN_EXCHANGE_NO_WAIT)
                break;
#endif
                if ((unsigned)__builtin_amdgcn_readfirstlane(__hip_atomic_load(cnt + 64 * u.pm, __ATOMIC_RELAXED, __HIP_MEMORY_SCOPE_AGENT)) >= want) break;
                if (__builtin_amdgcn_s_memrealtime() - t0 > 2000000ull) {
                    if (lane == 0) { unsigned expect = 0u; __hip_atomic_compare_exchange_strong(tmo + 1, &expect, code | (unsigned)(u.pm & 0xff), __ATOMIC_RELAXED, __ATOMIC_RELAXED, __HIP_MEMORY_SCOPE_AGENT);
                                     __hip_atomic_store(tmo, 1u, __ATOMIC_RELAXED, __HIP_MEMORY_SCOPE_AGENT); }
                    dead = true; break; }
                __builtin_amdgcn_s_sleep(2);
            }
            __builtin_amdgcn_fence(__ATOMIC_ACQUIRE, "agent");
            if (lane == 0) flag[0] = dead ? 1u : 0u;
        }
        asm volatile("s_waitcnt vmcnt(0) lgkmcnt(0)" ::: "memory"); __builtin_amdgcn_s_barrier(); asm volatile("" ::: "memory");
        const bool bad = flag[0] != 0u;
        if (lane < 32) {
            const unsigned long long* slot = (const unsigned long long*)xbuf + (size_t)(u.pm * BM + row) * 4; float mt[4], m2[4]; float ms = 0.f;
#pragma unroll
            for (int t = 0; t < 4; ++t) { if (t < ntn) { const unsigned long long w = __hip_atomic_load(slot + t, __ATOMIC_RELAXED, __HIP_MEMORY_SCOPE_AGENT); mt[t] = __uint_as_float((unsigned)w); m2[t] = __uint_as_float((unsigned)(w >> 32)); } else { mt[t] = 0.f; m2[t] = 0.f; } ms += mt[t]; }
            const float mean = ms / (float)ntn; float q = 0.f;
#pragma unroll
            for (int t = 0; t < 4; ++t) if (t < ntn) { const float dm = mt[t] - mean; q += m2[t] + 256.0f * dm * dm; }
            S[row] = (f32x2v){mean, 1.0f / sqrtf(q / (256.0f * (float)ntn) + eps)};
        }
        asm volatile("s_waitcnt lgkmcnt(0)" ::: "memory"); __builtin_amdgcn_s_barrier(); asm volatile("" ::: "memory");
        return bad;
    }
};
struct EpiLnRes {
    static constexpr bool PERM = false, AFTER_DRAIN = true;
    const float* base; float* out; int ldc; const float* bias; PanelStats st; unsigned poison;
    __device__ __forceinline__ void fused(f32x4 (&acc)[2][2][4][2], const Unit& u, int wr, int wc, int fr, int fq, PG8_LAS unsigned char* lds, int wid, int lane) const {
        typedef float f32x2v __attribute__((ext_vector_type(2)));
        const PG8_LAS f32x2v* S = (const PG8_LAS f32x2v*)(lds + 8192);
        const int col0 = u.pn * BM + wc * 32 + 4 * fq;
#pragma unroll
        for (int bj = 0; bj < 2; ++bj)
#pragma unroll
            for (int n = 0; n < 2; ++n) { const f32x4 bv = bias ? *(const f32x4*)(bias + col0 + bj * HALF + n * 16) : (f32x4){0.f, 0.f, 0.f, 0.f};
#pragma unroll
                for (int ai = 0; ai < 2; ++ai)
#pragma unroll
                    for (int m = 0; m < 4; ++m) acc[ai][bj][m][n] += bv; }
        f32x4 pre[4][2][2];
#pragma unroll
        for (int m = 0; m < 4; ++m) { const size_t off = (size_t)(u.pm * BM + wr * 64 + m * 16 + fr) * ldc + col0;
#pragma unroll
            for (int bj = 0; bj < 2; ++bj)
#pragma unroll
                for (int n = 0; n < 2; ++n) pre[m][bj][n] = *(const f32x4*)(base + off + bj * HALF + n * 16); }
        const bool bad = st.run(acc, u, wr, wc, fr, fq, lds, wid, lane) || poison != 0u;
        const float qnan = __builtin_nanf("");
#pragma unroll
        for (int ai = 0; ai < 2; ++ai)
#pragma unroll
            for (int m = 0; m < 4; ++m) { const int r = ai * HALF + wr * 64 + m * 16 + fr; const f32x2v sr = S[r]; const size_t off = (size_t)(u.pm * BM + r) * ldc + col0;
#pragma unroll
                for (int bj = 0; bj < 2; ++bj)
#pragma unroll
                    for (int n = 0; n < 2; ++n) { const f32x4 bs = ai == 0 ? pre[m][bj][n] : *(const f32x4*)(base + off + bj * HALF + n * 16); f32x4 o = bs + (acc[ai][bj][m][n] - sr.x) * sr.y;
                        if (bad) o = (f32x4){qnan, qnan, qnan, qnan}; *(f32x4*)(out + off + bj * HALF + n * 16) = o; }
                if (m & 1) asm volatile("" ::: "memory"); }
    }
};
struct EpiLnResLn {
    static constexpr bool PERM = false, AFTER_DRAIN = true;
    const float* base; float* out; bf16_t* xn; int ldc; const float* bias; PanelStats st1, st2; unsigned poison;
    __device__ __forceinline__ void fused(f32x4 (&acc)[2][2][4][2], const Unit& u, int wr, int wc, int fr, int fq, PG8_LAS unsigned char* lds, int wid, int lane) const {
        typedef float f32x2v __attribute__((ext_vector_type(2))); typedef unsigned u32x2v __attribute__((ext_vector_type(2)));
        const PG8_LAS f32x2v* S = (const PG8_LAS f32x2v*)(lds + 8192);
        const int col0 = u.pn * BM + wc * 32 + 4 * fq;
#pragma unroll
        for (int bj = 0; bj < 2; ++bj)
#pragma unroll
            for (int n = 0; n < 2; ++n) { const f32x4 bv = bias ? *(const f32x4*)(bias + col0 + bj * HALF + n * 16) : (f32x4){0.f, 0.f, 0.f, 0.f};
#pragma unroll
                for (int ai = 0; ai < 2; ++ai)
#pragma unroll
                    for (int m = 0; m < 4; ++m) acc[ai][bj][m][n] += bv; }
        bool bad = st1.run(acc, u, wr, wc, fr, fq, lds, wid, lane) || poison != 0u;
        const float qnan = __builtin_nanf("");
#pragma unroll
        for (int ai = 0; ai < 2; ++ai)
#pragma unroll
            for (int m = 0; m < 4; ++m) { const int r = ai * HALF + wr * 64 + m * 16 + fr; const f32x2v sr = S[r]; const size_t off = (size_t)(u.pm * BM + r) * ldc + col0;
#pragma unroll
                for (int bj = 0; bj < 2; ++bj)
#pragma unroll
                    for (int n = 0; n < 2; ++n) { const f32x4 bs = *(const f32x4*)(base + off + bj * HALF + n * 16); acc[ai][bj][m][n] = bs + (acc[ai][bj][m][n] - sr.x) * sr.y; }
                asm volatile("" : "+v"(acc[ai][0][m][0]), "+v"(acc[ai][0][m][1]), "+v"(acc[ai][1][m][0]), "+v"(acc[ai][1][m][1]));
                if (m & 1) asm volatile("" ::: "memory"); }
        const bool bad1 = bad;
        bad = st2.run(acc, u, wr, wc, fr, fq, lds, wid, lane) || bad;
#pragma unroll
        for (int ai = 0; ai < 2; ++ai)
#pragma unroll
            for (int m = 0; m < 4; ++m) { const int r = ai * HALF + wr * 64 + m * 16 + fr; const f32x2v sr = S[r]; const size_t off = (size_t)(u.pm * BM + r) * ldc + col0;
#pragma unroll
                for (int bj = 0; bj < 2; ++bj)
#pragma unroll
                    for (int n = 0; n < 2; ++n) { const f32x4 x1 = acc[ai][bj][m][n]; *(f32x4*)(out + off + bj * HALF + n * 16) = bad1 ? (f32x4){qnan, qnan, qnan, qnan} : x1;
                        const f32x4 o = (x1 - sr.x) * sr.y; u32x2v w; w.x = cvt_pk_bf16(o[0], o[1]); w.y = cvt_pk_bf16(o[2], o[3]);
                        if (bad) { w.x = 0x7fc07fc0u; w.y = 0x7fc07fc0u; } *(u32x2v*)(xn + off + bj * HALF + n * 16) = w; }
                asm volatile("" ::: "memory"); }
    }
};

template <class Epi, class Sched, bool ALIGN_EPI = false, bool SP2 = false>
__device__ __forceinline__ void gemm_phase(PG8_LAS unsigned char* lds, const Gemm g, const Sched& S, const Epi& E) {
    const int tid = threadIdx.x, wid = __builtin_amdgcn_readfirstlane(tid >> 6), lane = tid & 63, wr = wid >> 2, wc = wid & 3, fr = lane & 15, fq = lane >> 4;
    const int K = g.K, nt = K / BK;
    unsigned voffA[2], voffB[2];
#pragma unroll
    for (int i = 0; i < 2; ++i) { int R, C; stage_rc(tid * 16 + i * 8192, R, C); const int Rb = Epi::PERM ? ((R & ~31) + perm32(R & 31)) : R;
        voffA[i] = (unsigned)(R * K + C) * 2u; voffB[i] = (unsigned)(Rb * K + C) * 2u; }
    const size_t kstep = (size_t)(BK * 2);
    const size_t hstep = (size_t)HALF * K * 2;
    const size_t tstep = 2 * hstep;
    const unsigned ldsw = (unsigned)wid * 1024u;
    const int aoff = lds_byte(wr * 64 + fr, fq * 8), boff = lds_byte(wc * 32 + fr, fq * 8);
#define PG8_SA(b, h) (((b) * 2 + (h)) * HTB)
#define PG8_SB(b, h) ((4 + (b) * 2 + (h)) * HTB)
#define PG8_STAGE(bufoff, gbase, voff) do { _Pragma("unroll") for (int _i = 0; _i < 2; ++_i) \
        __builtin_amdgcn_global_load_lds((const unsigned*)((const char*)(gbase) + (voff)[_i]), (PG8_LAS unsigned*)(lds + (bufoff) + ldsw + _i * 8192), 16, 0, 0); } while (0)
#define PG8_LDA(dst, b, h) do { _Pragma("unroll") for (int m = 0; m < 4; ++m) _Pragma("unroll") for (int k = 0; k < 2; ++k) dst[m][k] = *(const PG8_LAS bf16x8*)(lds + PG8_SA(b, h) + aoff + m * 2048 + k * 1024); } while (0)
#define PG8_LDB(dst, b, h) do { _Pragma("unroll") for (int n = 0; n < 2; ++n) _Pragma("unroll") for (int k = 0; k < 2; ++k) dst[n][k] = *(const PG8_LAS bf16x8*)(lds + PG8_SB(b, h) + boff + n * 2048 + k * 1024); } while (0)
#define PG8_MMA(ai, bj, At, Bt) do { __builtin_amdgcn_s_setprio(1); _Pragma("unroll") for (int m = 0; m < 4; ++m) _Pragma("unroll") for (int n = 0; n < 2; ++n) _Pragma("unroll") for (int k = 0; k < 2; ++k) \
        acc[ai][bj][m][n] = __builtin_amdgcn_mfma_f32_16x16x32_bf16(Bt[n][k], At[m][k], acc[ai][bj][m][n], 0, 0, 0); __builtin_amdgcn_s_setprio(0); } while (0)
#define PG8_WAIT_V(n) asm volatile("s_waitcnt vmcnt(" #n ")" ::: "memory")
#define PG8_WAIT_L(n) asm volatile("s_waitcnt lgkmcnt(" #n ")" ::: "memory")
#define PG8_BAR __builtin_amdgcn_s_barrier()
#define PG8_SCHED __builtin_amdgcn_sched_barrier(0)
    Unit cur, nxt; int ui = 0;
    if (!S.next(0, cur)) return;
    f32x4 acc[2][2][4][2];
#pragma unroll
    for (int a = 0; a < 2; ++a)
#pragma unroll
        for (int b = 0; b < 2; ++b)
#pragma unroll
            for (int m = 0; m < 4; ++m)
#pragma unroll
                for (int n = 0; n < 2; ++n) acc[a][b][m][n] = (f32x4){0.f, 0.f, 0.f, 0.f};
    bf16x8 At[4][2], B0[2][2], B1[2][2];
    const char* cA = (const char*)g.A + (size_t)cur.pm * tstep; const char* cB = (const char*)g.Bt + (size_t)cur.pn * tstep;
    S.a_ready(cur);
    if constexpr (SP2) {
        PG8_STAGE(PG8_SB(0, 0), cB, voffB); PG8_STAGE(PG8_SB(0, 1), cB + hstep, voffB); PG8_STAGE(PG8_SA(0, 0), cA, voffA); PG8_STAGE(PG8_SA(0, 1), cA + hstep, voffA);
        if (wr == 1) PG8_BAR;
        PG8_WAIT_V(2); PG8_BAR;
        PG8_STAGE(PG8_SB(1, 0), cB + kstep, voffB); PG8_STAGE(PG8_SA(1, 0), cA + kstep, voffA); PG8_STAGE(PG8_SB(1, 1), cB + hstep + kstep, voffB);
        PG8_WAIT_V(6); PG8_BAR;
    } else {
        PG8_STAGE(PG8_SB(0, 0), cB, voffB); PG8_STAGE(PG8_SA(0, 0), cA, voffA); PG8_STAGE(PG8_SB(0, 1), cB + hstep, voffB); PG8_STAGE(PG8_SA(0, 1), cA + hstep, voffA);
        if (wr == 1) PG8_BAR;
        PG8_WAIT_V(4); PG8_BAR;
        PG8_STAGE(PG8_SB(1, 0), cB + kstep, voffB); PG8_STAGE(PG8_SA(1, 0), cA + kstep, voffA); PG8_STAGE(PG8_SB(1, 1), cB + hstep + kstep, voffB);
        PG8_WAIT_V(6); PG8_BAR;
    }
    for (;;) {
        const bool has_next = S.next(ui + 1, nxt);
        const char* nA = has_next ? (const char*)g.A + (size_t)nxt.pm * tstep : cA; const char* nB = has_next ? (const char*)g.Bt + (size_t)nxt.pn * tstep : cB;
        for (int t = 0; t < nt; t += 2) {
            const bool last = (t == nt - 2);
            const char* a1 = cA + (size_t)(t + 1) * kstep;
            const char* a2 = last ? nA : cA + (size_t)(t + 2) * kstep; const char* b2 = last ? nB : cB + (size_t)(t + 2) * kstep;
            const char* a3 = a2 + kstep; const char* b3 = b2 + kstep;
            if (last && has_next) S.a_ready(nxt);
            if constexpr (SP2) {
            PG8_LDB(B0, 0, 0); PG8_LDB(B1, 0, 1); PG8_SCHED; PG8_LDA(At, 0, 0); PG8_STAGE(PG8_SA(1, 1), a1 + hstep, voffA);
            PG8_WAIT_V(8); PG8_WAIT_L(0); PG8_BAR; PG8_MMA(0, 0, At, B0); PG8_MMA(0, 1, At, B1); PG8_BAR; PG8_SCHED;
            PG8_LDA(At, 0, 1); PG8_STAGE(PG8_SB(0, 0), b2, voffB); PG8_STAGE(PG8_SB(0, 1), b2 + hstep, voffB); PG8_STAGE(PG8_SA(0, 0), a2, voffA);
            PG8_WAIT_V(8); PG8_WAIT_L(0); PG8_BAR; PG8_MMA(1, 0, At, B0); PG8_MMA(1, 1, At, B1); PG8_BAR; PG8_SCHED;
            PG8_LDB(B0, 1, 0); PG8_LDB(B1, 1, 1); PG8_SCHED; PG8_LDA(At, 1, 0); PG8_STAGE(PG8_SA(0, 1), a2 + hstep, voffA);
            PG8_WAIT_V(8); PG8_WAIT_L(0); PG8_BAR; PG8_MMA(0, 0, At, B0); PG8_MMA(0, 1, At, B1); PG8_BAR; PG8_SCHED;
            PG8_LDA(At, 1, 1); PG8_STAGE(PG8_SB(1, 0), b3, voffB); PG8_STAGE(PG8_SB(1, 1), b3 + hstep, voffB); PG8_STAGE(PG8_SA(1, 0), a3, voffA);
            PG8_WAIT_V(8); PG8_WAIT_L(0); PG8_BAR; PG8_MMA(1, 0, At, B0); PG8_MMA(1, 1, At, B1); PG8_BAR; PG8_SCHED;
            } else {
            PG8_LDB(B0, 0, 0); PG8_SCHED; PG8_LDA(At, 0, 0); PG8_STAGE(PG8_SA(1, 1), a1 + hstep, voffA);
            PG8_WAIT_L(8); PG8_BAR; PG8_WAIT_L(0); PG8_MMA(0, 0, At, B0); PG8_BAR; PG8_SCHED;
            PG8_LDB(B1, 0, 1); PG8_STAGE(PG8_SB(0, 0), b2, voffB);
            PG8_BAR; PG8_WAIT_L(0); PG8_MMA(0, 1, At, B1); PG8_BAR;
            PG8_LDA(At, 0, 1); PG8_STAGE(PG8_SA(0, 0), a2, voffA);
            PG8_BAR; PG8_WAIT_L(0); PG8_MMA(1, 0, At, B0); PG8_BAR; PG8_SCHED;
            PG8_STAGE(PG8_SB(0, 1), b2 + hstep, voffB);
            PG8_WAIT_V(6); PG8_BAR; PG8_MMA(1, 1, At, B1); PG8_BAR;
            PG8_LDB(B0, 1, 0); PG8_SCHED; PG8_LDA(At, 1, 0); PG8_STAGE(PG8_SA(0, 1), a2 + hstep, voffA);
            PG8_WAIT_L(8); PG8_BAR; PG8_WAIT_L(0); PG8_MMA(0, 0, At, B0); PG8_BAR; PG8_SCHED;
            PG8_LDB(B1, 1, 1); PG8_STAGE(PG8_SB(1, 0), b3, voffB);
            PG8_BAR; PG8_WAIT_L(0); PG8_MMA(0, 1, At, B1); PG8_BAR;
            PG8_LDA(At, 1, 1); PG8_STAGE(PG8_SA(1, 0), a3, voffA);
            PG8_BAR; PG8_WAIT_L(0); PG8_MMA(1, 0, At, B0); PG8_BAR; PG8_SCHED;
            PG8_STAGE(PG8_SB(1, 1), b3 + hstep, voffB);
            PG8_WAIT_V(6); PG8_BAR; PG8_MMA(1, 1, At, B1); PG8_BAR;
            }
        }
        if constexpr (ALIGN_EPI) { if (wr == 0) PG8_BAR; }
        if constexpr (!Epi::AFTER_DRAIN) { E(acc, cur, wr, wc, fr, fq); S.done(cur); }
        if (!has_next) break;
#pragma unroll
        for (int a = 0; a < 2; ++a)
#pragma unroll
            for (int b = 0; b < 2; ++b)
#pragma unroll
                for (int m = 0; m < 4; ++m)
#pragma unroll
                    for (int n = 0; n < 2; ++n) acc[a][b][m][n] = (f32x4){0.f, 0.f, 0.f, 0.f};
        cur = nxt; cA = nA; cB = nB; ++ui;
        if constexpr (ALIGN_EPI) { if (wr == 1) PG8_BAR; }
    }
    PG8_WAIT_V(0);
    if constexpr (!ALIGN_EPI) { if (wr == 0) PG8_BAR; }
    PG8_BAR;
    if constexpr (Epi::AFTER_DRAIN) { E.fused(acc, cur, wr, wc, fr, fq, lds, wid, lane); S.done(cur); }
#undef PG8_SA
#undef PG8_SB
#undef PG8_STAGE
#undef PG8_LDA
#undef PG8_LDB
#undef PG8_MMA
#undef PG8_WAIT_V
#undef PG8_WAIT_L
#undef PG8_BAR
#undef PG8_SCHED
}
}

namespace pg8 {
constexpr float RMS_EPS = 1e-6f;
__device__ __forceinline__ float row_rstd(const float* ss, int row) {
    const f32x4* p = (const f32x4*)(ss + (size_t)row * 16); const f32x4 a = p[0], b = p[1], c = p[2], d = p[3];
    const float s = (((a[0] + a[1]) + (a[2] + a[3])) + ((b[0] + b[1]) + (b[2] + b[3]))) + (((c[0] + c[1]) + (c[2] + c[3])) + ((d[0] + d[1]) + (d[2] + d[3])));
    return 1.0f / sqrtf(s * (1.0f / 1024.0f) + RMS_EPS);
}
__device__ __forceinline__ float silu_f(float g) { return g * __builtin_amdgcn_rcpf(1.0f + __builtin_amdgcn_exp2f(-1.4426950408889634f * g)); }
struct EpiSwiGLU {
    static constexpr bool PERM = true, AFTER_DRAIN = false;
    bf16_t* H; int ldh; const float* ss;
    __device__ __forceinline__ void operator()(const f32x4 (&acc)[2][2][4][2], const Unit& u, int wr, int wc, int fr, int fq) const {
        const int row0 = u.pm * BM + wr * 64 + fr, col0 = u.pn * 128 + wc * 32 + 8 * fq;
#pragma unroll
        for (int ai = 0; ai < 2; ++ai)
#pragma unroll
            for (int m = 0; m < 4; ++m) { const int row = row0 + ai * HALF + m * 16; const float rs = row_rstd(ss, row);
                float h[8];
#pragma unroll
                for (int n = 0; n < 2; ++n)
#pragma unroll
                    for (int e = 0; e < 4; ++e) { const float g = acc[ai][0][m][n][e] * rs, up = acc[ai][1][m][n][e] * rs; h[n * 4 + e] = silu_f(g) * up; }
                u32x4 w; w.x = cvt_pk_bf16(h[0], h[1]); w.y = cvt_pk_bf16(h[2], h[3]); w.z = cvt_pk_bf16(h[4], h[5]); w.w = cvt_pk_bf16(h[6], h[7]);
                *(u32x4*)(H + (size_t)row * ldh + col0) = w; }
    }
};
struct EpiProj {
    static constexpr bool PERM = true, AFTER_DRAIN = false;
    bf16_t* PA; bf16_t* PR; const float* ss;
    __device__ __forceinline__ void operator()(const f32x4 (&acc)[2][2][4][2], const Unit& u, int wr, int wc, int fr, int fq) const {
        const int row0 = u.pm * BM + wr * 64 + fr; const int cin = wc * 32 + 8 * fq;
        bf16_t* base; int ld;
        if (u.pn < 4) { base = PA + u.pn * 256 + cin; ld = 1024; } else { base = PR + (u.pn - 4) * 256 + cin; ld = 2560; }
#pragma unroll
        for (int ai = 0; ai < 2; ++ai)
#pragma unroll
            for (int m = 0; m < 4; ++m) { const int row = row0 + ai * HALF + m * 16; const float rs = row_rstd(ss, row);
#pragma unroll
                for (int bj = 0; bj < 2; ++bj) { const f32x4 v0 = acc[ai][bj][m][0] * rs, v1 = acc[ai][bj][m][1] * rs;
                    u32x4 w; w.x = cvt_pk_bf16(v0[0], v0[1]); w.y = cvt_pk_bf16(v0[2], v0[3]); w.z = cvt_pk_bf16(v1[0], v1[1]); w.w = cvt_pk_bf16(v1[2], v1[3]);
                    *(u32x4*)(base + (size_t)row * ld + bj * HALF) = w; } }
    }
};
struct EpiResid {
    static constexpr bool PERM = true, AFTER_DRAIN = false;
    const float* base; float* out; bf16_t* xb; float* ss; float scale;
    __device__ __forceinline__ void operator()(const f32x4 (&acc)[2][2][4][2], const Unit& u, int wr, int wc, int fr, int fq) const {
        const int row0 = u.pm * BM + wr * 64 + fr, col0 = u.pn * BM + wc * 32 + 8 * fq;
#pragma unroll
        for (int ai = 0; ai < 2; ++ai)
#pragma unroll
            for (int m = 0; m < 4; ++m) { const int row = row0 + ai * HALF + m * 16; const size_t off = (size_t)row * 1024 + col0; float sq = 0.f;
#pragma unroll
                for (int bj = 0; bj < 2; ++bj) {
                    const f32x4 b0 = *(const f32x4*)(base + off + bj * HALF), b1 = *(const f32x4*)(base + off + bj * HALF + 4);
                    const f32x4 v0 = b0 + acc[ai][bj][m][0] * scale, v1 = b1 + acc[ai][bj][m][1] * scale;
                    *(f32x4*)(out + off + bj * HALF) = v0; *(f32x4*)(out + off + bj * HALF + 4) = v1;
                    sq += ((v0[0] * v0[0] + v0[1] * v0[1]) + (v0[2] * v0[2] + v0[3] * v0[3])) + ((v1[0] * v1[0] + v1[1] * v1[1]) + (v1[2] * v1[2] + v1[3] * v1[3]));
                    if (xb) { u32x4 w; w.x = cvt_pk_bf16(v0[0], v0[1]); w.y = cvt_pk_bf16(v0[2], v0[3]); w.z = cvt_pk_bf16(v1[0], v1[1]); w.w = cvt_pk_bf16(v1[2], v1[3]);
                        *(u32x4*)(xb + off + bj * HALF) = w; } }
                if (ss) { sq += __shfl_xor(sq, 16); sq += __shfl_xor(sq, 32); if (fq == 0) ss[(size_t)row * 16 + u.pn * 4 + wc] = sq; } }
    }
};
}

namespace att {
using bf16 = __hip_bfloat16;
constexpr int   D = 128, NW = 8, QBLK = 32, KVBLK = 64;
constexpr float SCALE = 0.088388347648318440f;
constexpr float THR = 8.f;
constexpr int SDEPTH = 2;
constexpr int LDQ = 1024, LDK = 1024, LDO = 512;
constexpr size_t SHM_V = KVBLK * D * 2, SHM_K = KVBLK * D * 2, SHM_ATTN = 2 * SHM_V + 2 * SHM_K + NW * 64 * 4;
using bf16x8 = __attribute__((ext_vector_type(8))) short;
using s16x4  = __attribute__((ext_vector_type(4))) short;
using f32x16 = __attribute__((ext_vector_type(16))) float;
using f32x8  = __attribute__((ext_vector_type(8))) float;
using u32x4  = __attribute__((ext_vector_type(4))) unsigned;
#define KSWZ(row, colB) ((row) * 256 + ((colB) ^ (((row) & 7) << 4)))
#define SBAR() __builtin_amdgcn_sched_barrier(0)
__device__ __forceinline__ int crow(int r, int hi) { return (r & 3) + 8 * (r >> 2) + 4 * hi; }
__device__ __forceinline__ unsigned cvtpk(float lo, float hi) {
  unsigned r; asm volatile("v_cvt_pk_bf16_f32 %0, %1, %2" : "=v"(r) : "v"(lo), "v"(hi)); return r;
}
template <typename TIn> struct Stage;
template <> struct Stage<bf16>  { using T = bf16x8;
  __device__ static __forceinline__ T ld8(const bf16* p) { return *reinterpret_cast<const bf16x8*>(p); }
  __device__ static __forceinline__ bf16x8 tobf(T x) { return x; } };
template <> struct Stage<float> { using T = f32x8;
  __device__ static __forceinline__ T ld8(const float* p) { return *reinterpret_cast<const f32x8*>(p); }
  __device__ static __forceinline__ bf16x8 tobf(T x) {
    u32x4 w = {cvtpk(x[0], x[1]), cvtpk(x[2], x[3]), cvtpk(x[4], x[5]), cvtpk(x[6], x[7])}; return *reinterpret_cast<bf16x8*>(&w); } };

__device__ __forceinline__ void partialSM(f32x16& p0, f32x16& p1, float& m_reg, float& mn, float& alpha) {
  constexpr float C = SCALE * 1.4426950408889634f;
  float pmax = p0[0]; for (int r = 1; r < 16; ++r) pmax = fmaxf(pmax, p0[r]); for (int r = 0; r < 16; ++r) pmax = fmaxf(pmax, p1[r]);
  { auto rr = __builtin_amdgcn_permlane32_swap(__float_as_uint(pmax), __float_as_uint(pmax), false, false);
    pmax = fmaxf(__uint_as_float(rr[0]), __uint_as_float(rr[1])); }
  if (__builtin_expect(__all(pmax - m_reg <= THR / SCALE), 1)) { mn = m_reg; alpha = 1.f; }
  else { mn = fmaxf(m_reg, pmax); alpha = __builtin_amdgcn_exp2f((m_reg - mn) * C); m_reg = mn; }
  float mnC = -mn * C;
  for (int r = 0; r < 16; ++r) p0[r] = fmaf(p0[r], C, mnC); for (int r = 0; r < 16; ++r) p1[r] = fmaf(p1[r], C, mnC);
  for (int r = 0; r < 16; ++r) p0[r] = __builtin_amdgcn_exp2f(p0[r]);
}
__device__ __forceinline__ void finishSM(f32x16& p0, f32x16& p1, float alpha, float& l_reg, bf16x8& pa0, bf16x8& pa1, bf16x8& pa2, bf16x8& pa3) {
  for (int r = 0; r < 16; ++r) p1[r] = __builtin_amdgcn_exp2f(p1[r]);
  float ps = 0; for (int r = 0; r < 16; ++r) ps += p0[r]; for (int r = 0; r < 16; ++r) ps += p1[r];
  { auto rr = __builtin_amdgcn_permlane32_swap(__float_as_uint(ps), __float_as_uint(ps), false, false);
    ps = __uint_as_float(rr[0]) + __uint_as_float(rr[1]); }
  l_reg = l_reg * alpha + ps;
#define PK4(P, BASE, OUT) do { unsigned a0 = cvtpk(P[BASE + 0], P[BASE + 1]), a1 = cvtpk(P[BASE + 2], P[BASE + 3]);   \
    unsigned b0 = cvtpk(P[BASE + 4], P[BASE + 5]), b1 = cvtpk(P[BASE + 6], P[BASE + 7]);                              \
    auto r0 = __builtin_amdgcn_permlane32_swap(a0, b0, false, false); auto r1 = __builtin_amdgcn_permlane32_swap(a1, b1, false, false); \
    u32x4 w = {r0[0], r1[0], r0[1], r1[1]}; OUT = *reinterpret_cast<bf16x8*>(&w); } while (0)
  PK4(p0, 0, pa0); PK4(p0, 8, pa1); PK4(p1, 0, pa2); PK4(p1, 8, pa3);
#undef PK4
}
__device__ __forceinline__ void qkt(f32x16& p0, f32x16& p1, const bf16* Ks, const bf16x8* qr, int r32, int hi) {
  p0 = f32x16{}; p1 = f32x16{};
  for (int d0 = 0; d0 < 8; ++d0) { int cb = (d0 * 16 + hi * 8) * 2;
    bf16x8 b0 = *reinterpret_cast<const bf16x8*>((const char*)Ks + KSWZ(r32, cb));
    bf16x8 b1 = *reinterpret_cast<const bf16x8*>((const char*)Ks + KSWZ(32 + r32, cb));
    p0 = __builtin_amdgcn_mfma_f32_32x32x16_bf16(b0, qr[d0], p0, 0, 0, 0);
    p1 = __builtin_amdgcn_mfma_f32_32x32x16_bf16(b1, qr[d0], p1, 0, 0, 0); }
}
__device__ __forceinline__ int v_st(int k, int c) { const int kk = (k & ~0xC) | ((k & 4) << 1) | ((k & 8) >> 1); return ((kk >> 3) * 4 + (c >> 5)) * 512 + ((kk & 7) * 32 + (c & 31)) * 2; }
__device__ __forceinline__ int v_rd_base(int lane) { return ((lane & 3) << 3) | (((lane >> 2) & 3) << 6) | (((lane >> 4) & 1) << 5) | (((lane >> 5) & 1) << 8); }
constexpr int v_rd_off(int d0, int ks, int half) { return d0 * 512 + ks * 4096 + half * 2048; }
template <int OFF> __device__ __forceinline__ s16x4 tr_read(int vb) {
  s16x4 r; asm volatile("ds_read_b64_tr_b16 %0, %1 offset:%2" : "=&v"(r) : "v"(vb), "i"(OFF) : "memory"); return r;
}
template <int D0> __device__ __forceinline__ void pv_one(f32x16& od, int vb, bf16x8 pa0, bf16x8 pa1, bf16x8 pa2, bf16x8 pa3) {
  const s16x4 l0 = tr_read<v_rd_off(D0, 0, 0)>(vb), h0 = tr_read<v_rd_off(D0, 0, 1)>(vb), l1 = tr_read<v_rd_off(D0, 1, 0)>(vb), h1 = tr_read<v_rd_off(D0, 1, 1)>(vb);
  const s16x4 l2 = tr_read<v_rd_off(D0, 2, 0)>(vb), h2 = tr_read<v_rd_off(D0, 2, 1)>(vb), l3 = tr_read<v_rd_off(D0, 3, 0)>(vb), h3 = tr_read<v_rd_off(D0, 3, 1)>(vb);
  asm volatile("s_waitcnt lgkmcnt(0)" ::: "memory"); SBAR();
#define PK(L, H) (bf16x8){L[0], L[1], L[2], L[3], H[0], H[1], H[2], H[3]}
  od = __builtin_amdgcn_mfma_f32_32x32x16_bf16(pa0, PK(l0, h0), od, 0, 0, 0);
  od = __builtin_amdgcn_mfma_f32_32x32x16_bf16(pa1, PK(l1, h1), od, 0, 0, 0);
  od = __builtin_amdgcn_mfma_f32_32x32x16_bf16(pa2, PK(l2, h2), od, 0, 0, 0);
  od = __builtin_amdgcn_mfma_f32_32x32x16_bf16(pa3, PK(l3, h3), od, 0, 0, 0);
#undef PK
}
__device__ __forceinline__ void pv_d0(f32x16* o, int vb, bf16x8 pa0, bf16x8 pa1, bf16x8 pa2, bf16x8 pa3) {
  pv_one<0>(o[0], vb, pa0, pa1, pa2, pa3); pv_one<1>(o[1], vb, pa0, pa1, pa2, pa3); pv_one<2>(o[2], vb, pa0, pa1, pa2, pa3); pv_one<3>(o[3], vb, pa0, pa1, pa2, pa3);
}

template <typename TQ>
__device__ __forceinline__ void attn_dense_body(const TQ* __restrict__ Qb, const bf16* __restrict__ Kh, const bf16* __restrict__ Vh,
                                                float* __restrict__ Ob, int seq, char* lds) {
  using St = Stage<bf16>; using SQ = Stage<TQ>;
  const int tid = threadIdx.x, wid = tid >> 6, lane = tid & 63, r32 = lane & 31, hi = lane >> 5;
  bf16* V_lds = (bf16*)lds; bf16* K_lds = (bf16*)(lds + 2 * SHM_V);
  float* ws = (float*)(lds + 2 * SHM_V + 2 * SHM_K) + wid * 64; float* li_l = ws; float* al_l = ws + 32;
  float m_reg = -1e30f, l_reg = 0; f32x16 o[4] = {}; bf16x8 qr[8];
  const TQ* Qw = Qb + (long)(wid * QBLK + r32) * LDQ + hi * 8;
#pragma unroll
  for (int d0 = 0; d0 < 8; ++d0) qr[d0] = SQ::tobf(SQ::ld8(Qw + d0 * 16));
  const int sr = tid >> 4, sc = (tid & 15) * 8, vst0 = v_st(sr, sc), vst1 = v_st(32 + sr, sc);
  const int vb0 = (int)(uintptr_t)V_lds + v_rd_base(lane);
  struct { typename St::T vs0, vs1, ks0, ks1; } sr_[SDEPTH];
#define SLOAD(i, k0) do { sr_[i].vs0 = St::ld8(&Vh[(long)((k0) + sr) * LDK + sc]); sr_[i].vs1 = St::ld8(&Vh[(long)((k0) + 32 + sr) * LDK + sc]); \
    sr_[i].ks0 = St::ld8(&Kh[(long)((k0) + sr) * LDK + sc]); sr_[i].ks1 = St::ld8(&Kh[(long)((k0) + 32 + sr) * LDK + sc]); } while (0)
#define SWRITE(b, i) do { *(bf16x8*)((char*)V_lds + (b) * SHM_V + vst0) = St::tobf(sr_[i].vs0);          \
    *(bf16x8*)((char*)V_lds + (b) * SHM_V + vst1) = St::tobf(sr_[i].vs1); int kc = sc * 2;               \
    *(bf16x8*)((char*)K_lds + (b) * SHM_K + KSWZ(sr, kc)) = St::tobf(sr_[i].ks0);                       \
    *(bf16x8*)((char*)K_lds + (b) * SHM_K + KSWZ(32 + sr, kc)) = St::tobf(sr_[i].ks1); } while (0)
#define SWAIT() do { if constexpr (SDEPTH == 2) asm volatile("s_waitcnt vmcnt(4)" ::: "memory"); else asm volatile("s_waitcnt vmcnt(0)" ::: "memory"); } while (0)
#define RESC(a) do { if (__any((a) < 1.f)) { if (hi == 0) al_l[r32] = (a); asm volatile("s_waitcnt lgkmcnt(0)" ::: "memory"); \
    for (int d = 0; d < 4; ++d) for (int r = 0; r < 16; ++r) o[d][r] *= al_l[crow(r, hi)]; } } while (0)
  f32x16 pA0, pA1, pB0, pB1; float mnA, mnB, alA, alB; bf16x8 pa0, pa1, pa2, pa3; const int NT = seq / KVBLK;
  constexpr int SE = 0, SO = SDEPTH - 1;
  SLOAD(SE, 0); asm volatile("s_waitcnt vmcnt(0)" ::: "memory"); SWRITE(0, SE); __syncthreads();
  qkt(pA0, pA1, K_lds, qr, r32, hi); partialSM(pA0, pA1, m_reg, mnA, alA);
  SLOAD(SO, KVBLK); if constexpr (SDEPTH == 2) { if (2 < NT) SLOAD(SE, 2 * KVBLK); }
  SWAIT(); SWRITE(1, SO); __syncthreads();
  for (int j = 1; j + 1 < NT; j += 2) {
    SBAR(); qkt(pB0, pB1, (bf16*)((char*)K_lds + SHM_K), qr, r32, hi);
    finishSM(pA0, pA1, alA, l_reg, pa0, pa1, pa2, pa3); SBAR();
    SLOAD(SO, (j + SDEPTH) * KVBLK); SBAR();
    pv_d0(o, vb0, pa0, pa1, pa2, pa3); partialSM(pB0, pB1, m_reg, mnB, alB);
    __syncthreads(); SWAIT(); SWRITE(0, SE);
    RESC(alB); __syncthreads();
    SBAR(); qkt(pA0, pA1, K_lds, qr, r32, hi);
    finishSM(pB0, pB1, alB, l_reg, pa0, pa1, pa2, pa3); SBAR();
    if (SDEPTH == 1 || j + 3 < NT) SLOAD(SE, (j + 1 + SDEPTH) * KVBLK); SBAR();
    pv_d0(o, vb0 + (int)SHM_V, pa0, pa1, pa2, pa3); partialSM(pA0, pA1, m_reg, mnA, alA);
    __syncthreads(); SWAIT(); SWRITE(1, SO);
    RESC(alA); __syncthreads();
  }
  SBAR(); qkt(pB0, pB1, (bf16*)((char*)K_lds + SHM_K), qr, r32, hi);
  finishSM(pA0, pA1, alA, l_reg, pa0, pa1, pa2, pa3); SBAR();
  pv_d0(o, vb0, pa0, pa1, pa2, pa3); partialSM(pB0, pB1, m_reg, mnB, alB);
  __syncthreads(); RESC(alB);
  finishSM(pB0, pB1, alB, l_reg, pa0, pa1, pa2, pa3); SBAR();
  pv_d0(o, vb0 + (int)SHM_V, pa0, pa1, pa2, pa3);
  if (hi == 0) li_l[r32] = l_reg; asm volatile("s_waitcnt lgkmcnt(0)" ::: "memory");
  float rli[16];
#pragma unroll
  for (int r = 0; r < 16; ++r) rli[r] = __builtin_amdgcn_rcpf(li_l[crow(r, hi)]);
  float* Ow = Ob + (long)(wid * QBLK) * LDO;
#pragma unroll
  for (int r = 0; r < 16; ++r) { int orow = crow(r, hi);
    for (int d0 = 0; d0 < 4; ++d0) Ow[(long)orow * LDO + d0 * 32 + r32] = o[d0][r] * rli[r]; }
#undef SLOAD
#undef SWRITE
#undef SWAIT
#undef RESC
}
}

namespace mk {
#define LAS __attribute__((address_space(3)))
typedef unsigned short bf16_t;
typedef short bf16x8 __attribute__((ext_vector_type(8)));
typedef float f32x4 __attribute__((ext_vector_type(4)));
typedef float f32x2 __attribute__((ext_vector_type(2)));
typedef float f32x16 __attribute__((ext_vector_type(16)));
typedef unsigned u32x4 __attribute__((ext_vector_type(4)));
typedef unsigned u32x2 __attribute__((ext_vector_type(2)));
constexpr int M = 16384, DM = 1024, T = 8192, FF = 2816, NIN = 3584, NTH = 512, NWAVES = 8;
constexpr int LDS_BYTES = 131072;
constexpr float EPS = 1e-6f, LOG2E = 1.4426950408889634f, LN2 = 0.6931471805599453f;
constexpr size_t WS_SSA = 0, WS_SSB = (size_t)1 << 20, WS_DC = (size_t)2 << 20, WS_ASS = (size_t)3 << 20, WS_W = (size_t)4 << 20;
constexpr size_t SZ_W1T = (size_t)2 * FF * DM * 2, SZ_W2T = (size_t)DM * FF * 2, SZ_WIN = (size_t)NIN * DM * 2, SZ_WO = (size_t)DM * DM * 2;
constexpr size_t WS_W1A = WS_W, WS_W2A = WS_W1A + SZ_W1T, WS_WIN = WS_W2A + SZ_W2T, WS_WO = WS_WIN + SZ_WIN, WS_W1B = WS_WO + SZ_WO, WS_W2B = WS_W1B + SZ_W1T;
constexpr size_t WS_X = WS_W2B + SZ_W2T;
constexpr size_t WS_B = WS_X + (size_t)M * DM * 2;
constexpr size_t WS_PR = WS_B + (size_t)M * 1024 * 2;
constexpr size_t WS_C = WS_B + (size_t)M * NIN * 2;
constexpr size_t WS_END = WS_C + (size_t)2048 * 16384 * 2;

__device__ __forceinline__ float bf_lo(unsigned u) { return __uint_as_float(u << 16); }
__device__ __forceinline__ float bf_hi(unsigned u) { return __uint_as_float(u & 0xffff0000u); }
__device__ __forceinline__ unsigned pk(float lo, float hi) { return pg8::cvt_pk_bf16(lo, hi); }
__device__ __forceinline__ float wave_sum(float v) {
#pragma unroll
    for (int o = 1; o < 64; o <<= 1) v += __shfl_xor(v, o);
    return v;
}
__device__ __forceinline__ float fexp(float x) { return __builtin_amdgcn_exp2f(x * LOG2E); }
__device__ __forceinline__ int crow(int r, int hi) { return (r & 3) + 8 * (r >> 2) + 4 * hi; }
#define LDSW() asm volatile("s_waitcnt lgkmcnt(0)" ::: "memory")

struct Args { const float* in[16]; float* out; unsigned char* ws; int lo, hi; };

__device__ __forceinline__ void tr_item(const float* W, int K, int N, bf16_t* WT, const float* gain, bool swiglu, LAS float* scr, int item, int lane) {
    const int nblk = N / 32, kb = item / nblk, nb = item % nblk, k0 = 64 * kb, n0 = 32 * nb;
#pragma unroll 8
    for (int i = 0; i < 32; ++i) { const int kk = 2 * i + (lane >> 5); float v = W[(size_t)(k0 + kk) * N + n0 + (lane & 31)]; if (gain) v *= gain[k0 + kk]; scr[kk * 33 + (lane & 31)] = v; }
    LDSW();
    int dst = n0;
    if (swiglu) { const int half = N / 2; dst = (n0 < half) ? (n0 / 128) * 256 + (n0 % 128) : ((n0 - half) / 128) * 256 + 128 + ((n0 - half) % 128); }
    const int c = lane & 7;
#pragma unroll
    for (int j = 0; j < 4; ++j) { const int n = (lane >> 3) + 8 * j; const LAS float* s = scr + (8 * c) * 33 + n;
        u32x4 o; o.x = pk(s[0 * 33], s[1 * 33]); o.y = pk(s[2 * 33], s[3 * 33]); o.z = pk(s[4 * 33], s[5 * 33]); o.w = pk(s[6 * 33], s[7 * 33]);
        *(u32x4*)(WT + (size_t)(dst + n) * K + k0 + 8 * c) = o; }
    LDSW();
}

__device__ __forceinline__ void rec_gates(const bf16_t* zp  , float lb0, float lb1, float (&g)[8][2], float (&kk)[8][2]) {
#pragma unroll
    for (int i = 0; i < 8; ++i) { const unsigned z = *(const unsigned*)(zp + (size_t)i * 2560);
        const float z0 = bf_lo(z), z1 = bf_hi(z);
        const float s0 = __builtin_amdgcn_rcpf(1.0f + fexp(-z0)), s1 = __builtin_amdgcn_rcpf(1.0f + fexp(-z1));
        const float f0 = lb0 + (1.0f - lb0) * s0, f1 = lb1 + (1.0f - lb1) * s1;
        g[i][0] = __builtin_amdgcn_logf(f0) * LN2; g[i][1] = __builtin_amdgcn_logf(f1) * LN2;
        kk[i][0] = (1.0f - lb0) * (1.0f - s0); kk[i][1] = (1.0f - lb1) * (1.0f - s1); }
}
__device__ __forceinline__ void seg_scan(float (&g)[8][2], int dir, float& t0, float& t1) {
    if (dir == 0) {
#pragma unroll
        for (int i = 1; i < 8; ++i) { g[i][0] += g[i - 1][0]; g[i][1] += g[i - 1][1]; }
        t0 = g[7][0]; t1 = g[7][1];
    } else {
#pragma unroll
        for (int i = 6; i >= 0; --i) { g[i][0] += g[i + 1][0]; g[i][1] += g[i + 1][1]; }
        t0 = g[0][0]; t1 = g[0][1];
    }
}
constexpr int R_VT = 0, R_KT = 18432, R_TS = 55296, R_QT = 63488, R_KT2 = 80896, R_QH = 98304, R_PB = 115712, R_OS = 63488;

__device__ __forceinline__ void lb_pair(const float* lbl, int dir, int ch, float& lb0, float& lb1) {
    const float a0 = lbl[dir * 1024 + ch], a1 = lbl[dir * 1024 + 512 + ch], b0 = lbl[dir * 1024 + ch + 1], b1 = lbl[dir * 1024 + 512 + ch + 1];
    lb0 = 1.0f / (1.0f + expf(a1 - a0)); lb1 = 1.0f / (1.0f + expf(b1 - b0));
}

__device__ __forceinline__ void rec_local(LAS unsigned char* lds, const bf16_t* PR, const float* lbl, bf16_t* LST, float* DC, int item, int tid) {
    const int b = item >> 9, h = (item >> 7) & 3, c = item & 127;
    const int lane = tid & 63, seg = tid >> 6, d0 = 2 * lane, r32 = lane & 31, hi = lane >> 5;
    const size_t row0 = (size_t)b * T + 64 * c + 8 * seg;
    {
        unsigned vv[8];
#pragma unroll
        for (int i = 0; i < 8; ++i) vv[i] = *(const unsigned*)(PR + (row0 + i) * 2560 + 1536 + h * 128 + d0);
        u32x4 lo, hi4;
        lo.x = (vv[0] & 0xffffu) | (vv[1] << 16); lo.y = (vv[2] & 0xffffu) | (vv[3] << 16); lo.z = (vv[4] & 0xffffu) | (vv[5] << 16); lo.w = (vv[6] & 0xffffu) | (vv[7] << 16);
        hi4.x = (vv[0] >> 16) | (vv[1] & 0xffff0000u); hi4.y = (vv[2] >> 16) | (vv[3] & 0xffff0000u); hi4.z = (vv[4] >> 16) | (vv[5] & 0xffff0000u); hi4.w = (vv[6] >> 16) | (vv[7] & 0xffff0000u);
        *(LAS u32x4*)(lds + R_VT + (d0 * 72 + 8 * seg) * 2) = lo; *(LAS u32x4*)(lds + R_VT + ((d0 + 1) * 72 + 8 * seg) * 2) = hi4;
    }
    float g[2][8][2], kk[2][8][2];
#pragma unroll
    for (int dir = 0; dir < 2; ++dir) {
        float lb0, lb1; lb_pair(lbl, dir, h * 128 + d0, lb0, lb1);
        rec_gates(PR + row0 * 2560 + 512 + dir * 512 + h * 128 + d0, lb0, lb1, g[dir], kk[dir]);
        float t0, t1; seg_scan(g[dir], dir, t0, t1);
        *(LAS f32x2*)(lds + R_TS + ((dir * 8 + seg) * 128 + d0) * 4) = (f32x2){t0, t1};
    }
    LDSW(); __syncthreads();
#pragma unroll
    for (int dir = 0; dir < 2; ++dir) {
        float off0 = 0.f, off1 = 0.f, tot0 = 0.f, tot1 = 0.f;
#pragma unroll
        for (int s = 0; s < 8; ++s) { const f32x2 t = *(const LAS f32x2*)(lds + R_TS + ((dir * 8 + s) * 128 + d0) * 4); tot0 += t.x; tot1 += t.y;
            const bool before = dir == 0 ? (s < seg) : (s > seg); if (before) { off0 += t.x; off1 += t.y; } }
        float k0[8], k1[8];
#pragma unroll
        for (int i = 0; i < 8; ++i) { k0[i] = kk[dir][i][0] * fexp(tot0 - (g[dir][i][0] + off0)); k1[i] = kk[dir][i][1] * fexp(tot1 - (g[dir][i][1] + off1)); }
#if defined(RL_TEST) && RL_TEST == 1
#pragma unroll
        for (int i = 0; i < 8; ++i) { k0[i] = 1.0f; k1[i] = 1.0f; }
#endif
        u32x4 w0, w1; w0.x = pk(k0[0], k0[1]); w0.y = pk(k0[2], k0[3]); w0.z = pk(k0[4], k0[5]); w0.w = pk(k0[6], k0[7]);
        w1.x = pk(k1[0], k1[1]); w1.y = pk(k1[2], k1[3]); w1.z = pk(k1[4], k1[5]); w1.w = pk(k1[6], k1[7]);
        *(LAS u32x4*)(lds + R_KT + dir * 18432 + (d0 * 72 + 8 * seg) * 2) = w0; *(LAS u32x4*)(lds + R_KT + dir * 18432 + ((d0 + 1) * 72 + 8 * seg) * 2) = w1;
        if (seg == 0) { const int chain = (b * 4 + h) * 2 + dir; *(f32x2*)(DC + ((size_t)(chain * 128 + c)) * 128 + d0) = (f32x2){fexp(tot0), fexp(tot1)}; }
    }
    LDSW(); __syncthreads();
    {
        const int dir = seg >> 2, mt = seg & 3;
        f32x16 acc[4];
#pragma unroll
        for (int n = 0; n < 4; ++n) acc[n] = (f32x16){};
#pragma unroll
        for (int ks = 0; ks < 4; ++ks) { const bf16x8 a = *(const LAS bf16x8*)(lds + R_VT + ((32 * mt + r32) * 72 + 16 * ks + 8 * hi) * 2);
#pragma unroll
            for (int n = 0; n < 4; ++n) { const bf16x8 bb = *(const LAS bf16x8*)(lds + R_KT + dir * 18432 + ((32 * n + r32) * 72 + 16 * ks + 8 * hi) * 2);
                acc[n] = __builtin_amdgcn_mfma_f32_32x32x16_bf16(a, bb, acc[n], 0, 0, 0); } }
        const int chain = (b * 4 + h) * 2 + dir; bf16_t* L = LST + ((size_t)(chain * 128 + c) << 14);
#pragma unroll
        for (int n = 0; n < 4; ++n)
#pragma unroll
            for (int r = 0; r < 16; ++r) { const int dv = 32 * mt + crow(r, hi), dk = 32 * n + r32; L[dv * 128 + dk] = (bf16_t)(pk(acc[n][r], 0.f) & 0xffffu); }
    }
    __syncthreads();
}

__device__ __forceinline__ void rec_out(LAS unsigned char* lds, const bf16_t* PR, const float* lbl, const bf16_t* SP, const float* AO, const float* ASS,
                                        const float* attn_gain, const float* rec_gain, bf16_t* MIX, int item, int h, float& ra, int tid) {
    const int b = item >> 7, c = item & 127;
    const int lane = tid & 63, seg = tid >> 6, d0 = 2 * lane, r32 = lane & 31, hi = lane >> 5;
    const size_t rowc = (size_t)b * T + 64 * c, row0 = rowc + 8 * seg;
    {
        unsigned vv[8];
#pragma unroll
        for (int i = 0; i < 8; ++i) vv[i] = *(const unsigned*)(PR + (row0 + i) * 2560 + 1536 + h * 128 + d0);
        u32x4 lo, hi4;
        lo.x = (vv[0] & 0xffffu) | (vv[1] << 16); lo.y = (vv[2] & 0xffffu) | (vv[3] << 16); lo.z = (vv[4] & 0xffffu) | (vv[5] << 16); lo.w = (vv[6] & 0xffffu) | (vv[7] << 16);
        hi4.x = (vv[0] >> 16) | (vv[1] & 0xffff0000u); hi4.y = (vv[2] >> 16) | (vv[3] & 0xffff0000u); hi4.z = (vv[4] >> 16) | (vv[5] & 0xffff0000u); hi4.w = (vv[6] >> 16) | (vv[7] & 0xffff0000u);
        *(LAS u32x4*)(lds + R_VT + (d0 * 72 + 8 * seg) * 2) = lo; *(LAS u32x4*)(lds + R_VT + ((d0 + 1) * 72 + 8 * seg) * 2) = hi4;
    }
    float q[8][2];
#pragma unroll
    for (int i = 0; i < 8; ++i) { const unsigned u = *(const unsigned*)(PR + (row0 + i) * 2560 + h * 128 + d0); q[i][0] = bf_lo(u); q[i][1] = bf_hi(u); }
    const int mt = seg >> 2, nt = seg & 3;
    const int bt = (seg >> 1) & 1, bs = seg & 1;
    f32x16 oacc = (f32x16){}, pacc = (f32x16){};
#pragma unroll 1
    for (int dir = 0; dir < 2; ++dir) {
        float g[8][2], kk[8][2];
        float lb0, lb1; lb_pair(lbl, dir, h * 128 + d0, lb0, lb1);
        rec_gates(PR + row0 * 2560 + 512 + dir * 512 + h * 128 + d0, lb0, lb1, g, kk);
        float t0, t1; seg_scan(g, dir, t0, t1);
        *(LAS f32x2*)(lds + R_TS + (seg * 128 + d0) * 4) = (f32x2){t0, t1};
        LDSW(); __syncthreads();
        float off0 = 0.f, off1 = 0.f, ref0 = 0.f, ref1 = 0.f;
#pragma unroll
        for (int s = 0; s < 8; ++s) { const f32x2 t = *(const LAS f32x2*)(lds + R_TS + (s * 128 + d0) * 4);
            const bool before = dir == 0 ? (s < seg) : (s > seg); if (before) { off0 += t.x; off1 += t.y; }
            const bool inref = dir == 0 ? (s < 4) : (s >= 4); if (inref) { ref0 += t.x; ref1 += t.y; } }
#pragma unroll
        for (int i = 0; i < 8; ++i) {
            const float b0 = g[i][0] + off0, b1 = g[i][1] + off1;
            const float eq0 = fexp(b0 - ref0), eq1 = fexp(b1 - ref1), ek0 = fexp(ref0 - b0), ek1 = fexp(ref1 - b1), eh0 = fexp(b0), eh1 = fexp(b1);
            const int ro = ((8 * seg + i) * 136 + d0) * 2;
            *(LAS unsigned*)(lds + R_QT + ro) = pk(q[i][0] * eq0, q[i][1] * eq1);
            *(LAS unsigned*)(lds + R_KT2 + ro) = pk(kk[i][0] * ek0, kk[i][1] * ek1);
            *(LAS unsigned*)(lds + R_QH + ro) = pk(q[i][0] * eh0, q[i][1] * eh1);
        }
        LDSW(); __syncthreads();
        if (seg < 4 && !((dir == 0 && bt == 0 && bs == 1) || (dir == 1 && bt == 1 && bs == 0))) {
            f32x16 sc = (f32x16){};
#pragma unroll
            for (int ks = 0; ks < 8; ++ks) {
                const bf16x8 a = *(const LAS bf16x8*)(lds + R_QT + ((32 * bt + r32) * 136 + 16 * ks + 8 * hi) * 2);
                const bf16x8 bb = *(const LAS bf16x8*)(lds + R_KT2 + ((32 * bs + r32) * 136 + 16 * ks + 8 * hi) * 2);
                sc = __builtin_amdgcn_mfma_f32_32x32x16_bf16(a, bb, sc, 0, 0, 0); }
#pragma unroll
            for (int r = 0; r < 16; ++r) { const int t = 32 * bt + crow(r, hi), s = 32 * bs + r32; const bool keep = dir == 0 ? (s <= t) : (s >= t); pacc[r] += keep ? sc[r] : 0.f; }
        }
        {
            const int chain = (b * 4 + h) * 2 + dir; const bf16_t* S = SP + ((size_t)(chain * 128 + c) << 14) + (size_t)(32 * nt + r32) * 128 + 8 * hi;
            bf16x8 sb[8];
#pragma unroll
            for (int ks = 0; ks < 8; ++ks) sb[ks] = *(const bf16x8*)(S + 16 * ks);
#pragma unroll
            for (int ks = 0; ks < 8; ++ks) { const bf16x8 a = *(const LAS bf16x8*)(lds + R_QH + ((32 * mt + r32) * 136 + 16 * ks + 8 * hi) * 2);
                oacc = __builtin_amdgcn_mfma_f32_32x32x16_bf16(a, sb[ks], oacc, 0, 0, 0); }
        }
        LDSW(); __syncthreads();
    }
    if (seg < 4) {
#pragma unroll
        for (int r = 0; r < 16; ++r) { const int t = 32 * bt + crow(r, hi), s = 32 * bs + r32; *(LAS bf16_t*)(lds + R_PB + (t * 72 + s) * 2) = (bf16_t)(pk(pacc[r], 0.f) & 0xffffu); }
    }
    LDSW(); __syncthreads();
#pragma unroll
    for (int ks = 0; ks < 4; ++ks) { const bf16x8 a = *(const LAS bf16x8*)(lds + R_PB + ((32 * mt + r32) * 72 + 16 * ks + 8 * hi) * 2);
        const bf16x8 bb = *(const LAS bf16x8*)(lds + R_VT + ((32 * nt + r32) * 72 + 16 * ks + 8 * hi) * 2);
        oacc = __builtin_amdgcn_mfma_f32_32x32x16_bf16(a, bb, oacc, 0, 0, 0); }
#pragma unroll
    for (int r = 0; r < 16; ++r) *(LAS float*)(lds + R_OS + ((32 * mt + crow(r, hi)) * 132 + 32 * nt + r32) * 4) = oacc[r];
    LDSW(); __syncthreads();
    {
        const int row = tid >> 3, sg = tid & 7; const size_t grow = rowc + row;
        f32x4 o4[4]; float ss = 0.f;
#pragma unroll
        for (int j = 0; j < 4; ++j) { o4[j] = *(const LAS f32x4*)(lds + R_OS + (row * 132 + 16 * sg + 4 * j) * 4); ss += (o4[j][0] * o4[j][0] + o4[j][1] * o4[j][1]) + (o4[j][2] * o4[j][2] + o4[j][3] * o4[j][3]); }
        ss += __shfl_xor(ss, 1); ss += __shfl_xor(ss, 2); ss += __shfl_xor(ss, 4);
        const float rstd = 1.0f / sqrtf(ss * (1.0f / 128.0f) + EPS);
        const u32x4 gz0 = *(const u32x4*)(PR + grow * 2560 + 2048 + h * 128 + 16 * sg), gz1 = *(const u32x4*)(PR + grow * 2560 + 2048 + h * 128 + 16 * sg + 8);
        const unsigned gz[8] = {gz0.x, gz0.y, gz0.z, gz0.w, gz1.x, gz1.y, gz1.z, gz1.w};
        float res[16];
#pragma unroll
        for (int e = 0; e < 16; ++e) { const float gt = (e & 1) ? bf_hi(gz[e >> 1]) : bf_lo(gz[e >> 1]); res[e] = o4[e >> 2][e & 3] * rstd * rec_gain[16 * sg + e] * pg8::silu_f(gt); }
        u32x4 w0, w1; w0.x = pk(res[0], res[1]); w0.y = pk(res[2], res[3]); w0.z = pk(res[4], res[5]); w0.w = pk(res[6], res[7]);
        w1.x = pk(res[8], res[9]); w1.y = pk(res[10], res[11]); w1.z = pk(res[12], res[13]); w1.w = pk(res[14], res[15]);
        *(u32x4*)(MIX + grow * 1024 + 512 + h * 128 + 16 * sg) = w0; *(u32x4*)(MIX + grow * 1024 + 512 + h * 128 + 16 * sg + 8) = w1;
        if (h == 0) { float sa = 0.f;
#pragma unroll
            for (int j = 0; j < 16; ++j) { const f32x4 a4 = *(const f32x4*)(AO + grow * 512 + 64 * sg + 4 * j); sa += (a4[0] * a4[0] + a4[1] * a4[1]) + (a4[2] * a4[2] + a4[3] * a4[3]); }
            sa += __shfl_xor(sa, 1); sa += __shfl_xor(sa, 2); sa += __shfl_xor(sa, 4);
            ra = 1.0f / sqrtf(sa * (1.0f / 512.0f) + EPS); }
        float av[16];
#pragma unroll
        for (int j = 0; j < 4; ++j) { const f32x4 a4 = *(const f32x4*)(AO + grow * 512 + h * 128 + 16 * sg + 4 * j); const f32x4 g4 = *(const f32x4*)(attn_gain + h * 128 + 16 * sg + 4 * j);
            av[4 * j + 0] = a4[0] * ra * g4[0]; av[4 * j + 1] = a4[1] * ra * g4[1]; av[4 * j + 2] = a4[2] * ra * g4[2]; av[4 * j + 3] = a4[3] * ra * g4[3]; }
        w0.x = pk(av[0], av[1]); w0.y = pk(av[2], av[3]); w0.z = pk(av[4], av[5]); w0.w = pk(av[6], av[7]);
        w1.x = pk(av[8], av[9]); w1.y = pk(av[10], av[11]); w1.z = pk(av[12], av[13]); w1.w = pk(av[14], av[15]);
        *(u32x4*)(MIX + grow * 1024 + h * 128 + 16 * sg) = w0; *(u32x4*)(MIX + grow * 1024 + h * 128 + 16 * sg + 8) = w1;
    }
    __syncthreads();
}

__device__ __forceinline__ void qk_norm_rope(bf16_t* PA, const float* qg, const float* kg, int gw, int ngw, int lane) {
    const int a = lane & 15, half = a >> 3, j0 = (a & 3) * 8; const bool isx2 = (a & 4) != 0;
    float invf[8];
#pragma unroll
    for (int e = 0; e < 8; ++e) invf[e] = __builtin_amdgcn_exp2f(-(float)(j0 + e) * 0.41524101186092029f) * 0.15915494309189535f;
    for (int gi = gw; gi < M * 6 / 4; gi += ngw) {
        const int vid = gi * 4 + (lane >> 4), row = vid / 6, hv = vid - row * 6;
        bf16_t* p = PA + (size_t)row * 1024 + hv * 128 + 8 * a;
        const u32x4 raw = *(const u32x4*)p; const unsigned rw[4] = {raw.x, raw.y, raw.z, raw.w};
        float x[8]; float ss = 0.f;
#pragma unroll
        for (int e = 0; e < 4; ++e) { x[2 * e] = bf_lo(rw[e]); x[2 * e + 1] = bf_hi(rw[e]); ss += x[2 * e] * x[2 * e] + x[2 * e + 1] * x[2 * e + 1]; }
        ss += __shfl_xor(ss, 1); ss += __shfl_xor(ss, 2); ss += __shfl_xor(ss, 4); ss += __shfl_xor(ss, 8);
        const float rstd = 1.0f / sqrtf(ss * (1.0f / 128.0f) + EPS);
        const float* gn = (hv < 4 ? qg : kg) + 8 * a;
        float y[8], yp[8];
#pragma unroll
        for (int e = 0; e < 8; ++e) y[e] = x[e] * rstd * gn[e];
#pragma unroll
        for (int e = 0; e < 8; ++e) yp[e] = __shfl_xor(y[e], 4);
        const int t = row & (T - 1); const float id = (float)(half ? (t & 63) : (t >> 6));
        float o[8];
#pragma unroll
        for (int e = 0; e < 8; ++e) { const float rev = id * invf[e], fr = rev - floorf(rev); const float cs = __builtin_amdgcn_cosf(fr), sn = __builtin_amdgcn_sinf(fr);
            o[e] = isx2 ? (y[e] * cs + yp[e] * sn) : (y[e] * cs - yp[e] * sn); }
        u32x4 w; w.x = pk(o[0], o[1]); w.y = pk(o[2], o[3]); w.z = pk(o[4], o[5]); w.w = pk(o[6], o[7]);
        *(u32x4*)p = w;
    }
}

__global__ void __launch_bounds__(NTH, 2) hybrid_fwd(Args args) {
    extern __shared__ __attribute__((aligned(16))) unsigned char lds_raw[];
    LAS unsigned char* lds = (LAS unsigned char*)lds_raw;
    const int tid = threadIdx.x, lane = tid & 63, wave = __builtin_amdgcn_readfirstlane(tid >> 6);
    const int G = gridDim.x, gw = blockIdx.x * NWAVES + wave, NGW = G * NWAVES;
    unsigned char* ws = args.ws;
    const float* x = args.in[0];
    float* out = args.out;
    float* SSA = (float*)(ws + WS_SSA); float* SSB = (float*)(ws + WS_SSB); float* DC = (float*)(ws + WS_DC); float* ASS = (float*)(ws + WS_ASS);
    bf16_t* W1A = (bf16_t*)(ws + WS_W1A); bf16_t* W2A = (bf16_t*)(ws + WS_W2A); bf16_t* WIN = (bf16_t*)(ws + WS_WIN); bf16_t* WO = (bf16_t*)(ws + WS_WO);
    bf16_t* W1B = (bf16_t*)(ws + WS_W1B); bf16_t* W2B = (bf16_t*)(ws + WS_W2B);
    bf16_t* XB = (bf16_t*)(ws + WS_X); float* AO = (float*)(ws + WS_X); bf16_t* X2B = (bf16_t*)(ws + WS_X);
    bf16_t* H = (bf16_t*)(ws + WS_B); bf16_t* PA = (bf16_t*)(ws + WS_B); bf16_t* PR = (bf16_t*)(ws + WS_PR); bf16_t* MIX = (bf16_t*)(ws + WS_B);
    bf16_t* LST = (bf16_t*)(ws + WS_C);
    const int lo = args.lo, hi = args.hi;
#ifdef PH_ONLY
#define IN(k) ((k) == PH_ONLY && lo <= (k) && (k) < hi)
#else
#define IN(k) (lo <= (k) && (k) < hi)
#endif
#define SEAM(k) do { if (IN(k) && IN((k) + 1)) { cg::this_grid().sync(); } } while (0)

    if (IN(0)) {
        LAS float* scr = (LAS float*)(lds + wave * 8448);
        constexpr int I1 = (DM / 64) * (2 * FF / 32), I2 = (FF / 64) * (DM / 32), I3 = (DM / 64) * (NIN / 32), I4 = (DM / 64) * (DM / 32);
        constexpr int NITEMS = 2 * I1 + 2 * I2 + I3 + I4;
        for (int it = gw; it < NITEMS; it += NGW) {
            int r = it;
            if (r < I1) { tr_item(args.in[2], DM, 2 * FF, W1A, args.in[1], true, scr, r, lane); continue; } r -= I1;
            if (r < I2) { tr_item(args.in[3], FF, DM, W2A, nullptr, false, scr, r, lane); continue; } r -= I2;
            if (r < I3) { tr_item(args.in[5], DM, NIN, WIN, args.in[4], false, scr, r, lane); continue; } r -= I3;
            if (r < I4) { tr_item(args.in[11], DM, DM, WO, nullptr, false, scr, r, lane); continue; } r -= I4;
            if (r < I1) { tr_item(args.in[13], DM, 2 * FF, W1B, args.in[12], true, scr, r, lane); continue; } r -= I1;
            tr_item(args.in[14], FF, DM, W2B, nullptr, false, scr, r, lane);
        }
        for (int m = gw; m < M; m += NGW) {
            const f32x4* xr = (const f32x4*)(x + (size_t)m * DM) + lane; f32x4 v[4]; float s = 0.f;
#pragma unroll
            for (int j = 0; j < 4; ++j) { v[j] = xr[64 * j]; s += (v[j][0] * v[j][0] + v[j][1] * v[j][1]) + (v[j][2] * v[j][2] + v[j][3] * v[j][3]); }
            s = wave_sum(s);
            u32x2* o8 = (u32x2*)(XB + (size_t)m * DM) + lane;
#pragma unroll
            for (int j = 0; j < 4; ++j) o8[64 * j] = (u32x2){pk(v[j][0], v[j][1]), pk(v[j][2], v[j][3])};
            if (lane < 16) SSA[(size_t)m * 16 + lane] = lane == 0 ? s : 0.f;
        }
        __syncthreads();
    }
    SEAM(0);
    if (IN(1)) { pg8::Gemm g{XB, W1A, M, 2 * FF, DM}; pg8::StaticOrder S; S.init(M, 2 * FF, G, (int)blockIdx.x); pg8::EpiSwiGLU E{H, FF, SSA};
        pg8::gemm_phase<pg8::EpiSwiGLU, pg8::StaticOrder, true, true>(lds, g, S, E); }
    SEAM(1);
    if (IN(2)) { pg8::Gemm g{H, W2A, M, DM, FF}; pg8::StaticOrder S; S.init(M, DM, G, (int)blockIdx.x); pg8::EpiResid E{x, out, XB, SSB, 0.5f};
        pg8::gemm_phase<pg8::EpiResid, pg8::StaticOrder, true, true>(lds, g, S, E); }
    SEAM(2);
    if (IN(3)) { pg8::Gemm g{XB, WIN, M, NIN, DM}; pg8::StaticOrder S; S.init(M, NIN, G, (int)blockIdx.x); pg8::EpiProj E{PA, PR, SSB};
        pg8::gemm_phase<pg8::EpiProj, pg8::StaticOrder, true, true>(lds, g, S, E); }
    SEAM(3);
    if (IN(4)) {
        qk_norm_rope(PA, args.in[6], args.in[7], gw, NGW, lane);
        for (int it = blockIdx.x; it < 1024; it += G) rec_local(lds, PR, args.in[9], LST, DC, it, tid);
    }
    SEAM(4);
    if (IN(5)) {
#ifndef X_NOSCAN
        for (int p = blockIdx.x * NTH + tid; p < 16 * 8192; p += G * NTH) {
            const int chain = p >> 13, pair = p & 8191, dk0 = (pair & 63) * 2, dir = chain & 1;
            float s0 = 0.f, s1 = 0.f;
#pragma unroll 8
            for (int st = 0; st < 128; ++st) { const int c = dir ? 127 - st : st;
                unsigned* ptr = (unsigned*)(LST + ((size_t)(chain * 128 + c) << 14)) + pair;
                const unsigned l = *ptr; const f32x2 dc = *(const f32x2*)(DC + (size_t)(chain * 128 + c) * 128 + dk0);
                *ptr = pk(s0, s1);
                s0 = dc.x * s0 + bf_lo(l); s1 = dc.y * s1 + bf_hi(l); }
        }
#endif
#ifdef X_NOLOOP
        { const int u = blockIdx.x;
#else
        for (int u = blockIdx.x; u < 256; u += G) {
#endif
            const int xcd = u & 7, j = u >> 3, pair = xcd >> 1, b = pair >> 1, kvh = pair & 1, h = 2 * kvh + (xcd & 1);
            const size_t r0 = (size_t)b * T + 256 * j;
            att::attn_dense_body<att::bf16>((const att::bf16*)(PA + r0 * 1024 + h * 128), (const att::bf16*)(PA + (size_t)b * T * 1024 + 512 + kvh * 128),
                                            (const att::bf16*)(PA + (size_t)b * T * 1024 + 768 + kvh * 128), AO + r0 * 512 + h * 128, T, (char*)lds_raw);
            __syncthreads();
        }
    }
    SEAM(5);
    if (IN(6)) { for (int it = blockIdx.x; it < 256; it += G) { float ra = 0.f;
#pragma unroll 1
        for (int h = 0; h < 4; ++h) rec_out(lds, PR, args.in[9], LST, AO, ASS, args.in[8], args.in[10], MIX, it, h, ra, tid); } }
    SEAM(6);
    if (IN(7)) { pg8::Gemm g{MIX, WO, M, DM, DM}; pg8::StaticOrder S; S.init(M, DM, G, (int)blockIdx.x); pg8::EpiResid E{out, out, X2B, SSA, 1.0f};
        pg8::gemm_phase<pg8::EpiResid, pg8::StaticOrder, true, true>(lds, g, S, E); }
    SEAM(7);
    if (IN(8)) { pg8::Gemm g{X2B, W1B, M, 2 * FF, DM}; pg8::StaticOrder S; S.init(M, 2 * FF, G, (int)blockIdx.x); pg8::EpiSwiGLU E{H, FF, SSA};
        pg8::gemm_phase<pg8::EpiSwiGLU, pg8::StaticOrder, true, true>(lds, g, S, E); }
    SEAM(8);
    if (IN(9)) { pg8::Gemm g{H, W2B, M, DM, FF}; pg8::StaticOrder S; S.init(M, DM, G, (int)blockIdx.x); pg8::EpiResid E{out, out, nullptr, nullptr, 0.5f};
        pg8::gemm_phase<pg8::EpiResid, pg8::StaticOrder, true, true>(lds, g, S, E); }
    SEAM(9);
    if (IN(10)) {
        const float* fg = args.in[15];
        for (int m = gw; m < M; m += NGW) {
            f32x4* xr = (f32x4*)(out + (size_t)m * DM) + lane; f32x4 v[4]; float s = 0.f;
#pragma unroll
            for (int j = 0; j < 4; ++j) { v[j] = xr[64 * j]; s += (v[j][0] * v[j][0] + v[j][1] * v[j][1]) + (v[j][2] * v[j][2] + v[j][3] * v[j][3]); }
            const float rstd = 1.0f / sqrtf(wave_sum(s) * (1.0f / DM) + EPS);
#pragma unroll
            for (int j = 0; j < 4; ++j) { const f32x4 gn = *((const f32x4*)fg + lane + 64 * j); xr[64 * j] = v[j] * rstd * gn; }
        }
    }
#undef IN
#undef SEAM
}
}

#ifdef DBG
__global__ void dbg_dump_bf16(const unsigned short* src, float* out, size_t n) { for (size_t i = blockIdx.x * (size_t)blockDim.x + threadIdx.x; i < n; i += (size_t)gridDim.x * blockDim.x) out[i] = __uint_as_float((unsigned)src[i] << 16); }
__global__ void dbg_dump_f32(const float* src, float* out, size_t n) { for (size_t i = blockIdx.x * (size_t)blockDim.x + threadIdx.x; i < n; i += (size_t)gridDim.x * blockDim.x) out[i] = src[i]; }
#endif
extern "C" void kernel_launch(void* const* d_in, const int* in_sizes, int n_in, void* d_out, int out_size, void* d_ws, size_t ws_size, hipStream_t stream) {
    using namespace mk;
    static int grid = 0;
    if (grid == 0) {
        if (n_in != 16 || in_sizes[0] != M * DM || out_size != M * DM || ws_size < WS_END) {
            fprintf(stderr, "kernel_launch: built for 16 inputs, x/out of %d floats, >= %zu bytes of workspace; got n_in %d in0 %d out %d ws %zu\n", M * DM, (size_t)WS_END, n_in, n_in > 0 ? in_sizes[0] : -1, out_size, ws_size);
            grid = -1; return; }
        int dev = 0, cus = 0, per_cu = 0;
        hipGetDevice(&dev); hipDeviceGetAttribute(&cus, hipDeviceAttributeMultiprocessorCount, dev);
        if (hipFuncSetAttribute((const void*)hybrid_fwd, hipFuncAttributeMaxDynamicSharedMemorySize, LDS_BYTES) != hipSuccess) { fprintf(stderr, "kernel_launch: hipFuncSetAttribute failed\n"); grid = -1; return; }
        if (hipOccupancyMaxActiveBlocksPerMultiprocessor(&per_cu, (const void*)hybrid_fwd, NTH, LDS_BYTES) != hipSuccess || per_cu < 1) { fprintf(stderr, "kernel_launch: occupancy query says %d\n", per_cu); per_cu = 1; }
        (void)hipGetLastError();
        grid = cus * per_cu; if (grid > 256) grid = 256;
    }
    if (grid < 0) return;
    Args a{};
    for (int i = 0; i < 16; ++i) a.in[i] = (const float*)d_in[i];
    a.out = (float*)d_out; a.ws = (unsigned char*)d_ws;
#if MK_LAUNCHES == 1
    a.lo = 0; a.hi = 11;
    void* kargs[] = {&a};
    hipError_t e = hipLaunchCooperativeKernel((const void*)hybrid_fwd, dim3(grid), dim3(NTH), kargs, LDS_BYTES, stream);
    if (e != hipSuccess) fprintf(stderr, "kernel_launch: cooperative launch failed: %s (grid %d)\n", hipGetErrorString(e), grid);
#else
#ifdef DBG
    const int last = DBG == 7 ? 3 : DBG == 6 ? 6 : DBG == 5 ? 5 : DBG == 4 ? 4 : DBG == 3 ? 3 : DBG == 1 ? 1 : 2;
    for (int ph = 0; ph <= last; ++ph) { a.lo = ph; a.hi = ph + 1; hipLaunchKernelGGL(hybrid_fwd, dim3(grid), dim3(NTH), LDS_BYTES, stream, a); }
    const size_t n = (size_t)M * DM; unsigned char* w = (unsigned char*)d_ws;
    if (DBG == 6) hipLaunchKernelGGL(dbg_dump_bf16, dim3(1024), dim3(256), 0, stream, (const unsigned short*)(w + WS_B), (float*)d_out, n);
    if (DBG == 5) hipLaunchKernelGGL(dbg_dump_f32, dim3(1024), dim3(256), 0, stream, (const float*)(w + WS_X), (float*)d_out, n / 2);
    if (DBG == 4) hipLaunchKernelGGL(dbg_dump_bf16, dim3(1024), dim3(256), 0, stream, (const unsigned short*)(w + WS_C), (float*)d_out, n);
    if (DBG == 3) hipLaunchKernelGGL(dbg_dump_bf16, dim3(1024), dim3(256), 0, stream, (const unsigned short*)(w + WS_B), (float*)d_out, n);
    if (DBG == 7) hipLaunchKernelGGL(dbg_dump_bf16, dim3(1024), dim3(256), 0, stream, (const unsigned short*)(w + WS_PR), (float*)d_out, n);
    if (DBG == 1) hipLaunchKernelGGL(dbg_dump_bf16, dim3(1024), dim3(256), 0, stream, (const unsigned short*)(w + WS_B), (float*)d_out, n);
#else
    for (int ph = 0; ph < 11; ++ph) { a.lo = ph; a.hi = ph + 1; hipLaunchKernelGGL(hybrid_fwd, dim3(grid), dim3(NTH), LDS_BYTES, stream, a); }
#endif
#endif
}
```

```cpp
#include <hip/hip_runtime.h>
#include <hip/hip_bf16.h>
#include <hip/hip_cooperative_groups.h>
#include <cstdio>
#include <cstdint>
namespace cg = cooperative_groups;
#ifndef MK_LAUNCHES
#define MK_LAUNCHES 1
#endif
namespace pg8 {
#define PG8_LAS __attribute__((address_space(3)))
typedef unsigned short bf16_t;
typedef short bf16x8 __attribute__((ext_vector_type(8)));
typedef float f32x4 __attribute__((ext_vector_type(4)));
typedef unsigned u32x4 __attribute__((ext_vector_type(4)));
constexpr int BM = 256, BK = 64, HALF = 128, HTB = HALF * BK * 2  , STAGE_BYTES = 8 * HTB, NXCD = 8, WGM = 8;

__host__ __device__ __forceinline__ int lds_byte(int r, int c) { const int st = (r >> 4) * 2 + (c >> 5), rr = r & 15, cc = c & 31, ob = rr * 64 + cc * 2; return st * 1024 + (ob ^ (((ob >> 9) & 1) << 5)); }
__host__ __device__ __forceinline__ void stage_rc(int b, int& R, int& C) { const int st = b / 1024, sb = b % 1024, swz = sb ^ (((sb >> 9) & 1) << 5); R = (st >> 1) * 16 + swz / 64; C = (st & 1) * 32 + (swz % 64) / 2; }
__host__ __device__ __forceinline__ int perm32(int rho) { const int n = rho >> 4, i = rho & 15; return 8 * (i >> 2) + 4 * n + (i & 3); }

struct Unit { int pm, pn; };
struct Gemm { const bf16_t* A; const bf16_t* Bt; int M, N, K; };

struct StaticOrder {
    int nM, nN, nwg, G, c;
    __host__ __device__ void init(int M, int N, int G_, int c_) { nM = M / BM; nN = N / BM; nwg = nM * nN; G = G_; c = c_; }
    __host__ __device__ bool next(int i, Unit& u) const {
        const long L = (long)i * G + c; if (L >= nwg) return false;
        int wgid = (int)L; { const int q = nwg / NXCD, r = nwg % NXCD, xcd = wgid % NXCD, off = wgid / NXCD; wgid = (xcd < r ? xcd * (q + 1) : r * (q + 1) + (xcd - r) * q) + off; }
        const int nig = WGM * nN, gid = wgid / nig, fm = gid * WGM, gsz = (nM - fm) < WGM ? (nM - fm) : WGM;
        u.pm = fm + ((wgid % nig) % gsz); u.pn = (wgid % nig) / gsz; return true;
    }
    __device__ __forceinline__ void a_ready(const Unit&) const {}
    __device__ __forceinline__ void done(const Unit&) const {}
};

typedef __bf16 bf16x2_cv __attribute__((ext_vector_type(2)));
typedef float f32x2_cv __attribute__((ext_vector_type(2)));
__device__ __forceinline__ unsigned cvt_pk_bf16(float lo, float hi) { const bf16x2_cv v = __builtin_convertvector((f32x2_cv){lo, hi}, bf16x2_cv); return __builtin_bit_cast(unsigned, v); }
typedef float f32x2 __attribute__((ext_vector_type(2)));
__device__ __forceinline__ f32x2 gelu_pk(f32x2 v) {
    const f32x2 av = __builtin_elementwise_abs(v), d = av * 0.2316418882f + 1.0f;
    f32x2 t; t.x = __builtin_amdgcn_rcpf(d.x); t.y = __builtin_amdgcn_rcpf(d.y);
    f32x2 q = t * 0.5307027145f + (-0.7265760135f); q = q * t + 0.7107068705f; q = q * t + (-0.142248368f); q = q * t + 0.127414796f; q = q * t;
    const f32x2 s = (v * v) * (-0.72134752044f);
    f32x2 e; e.x = __builtin_amdgcn_exp2f(s.x); e.y = __builtin_amdgcn_exp2f(s.y);
    const f32x2 m = v * (q * e), r = v - m;
    f32x2 o; o.x = v.x < 0.f ? m.x : r.x; o.y = v.y < 0.f ? m.y : r.y; return o;
}

template <int ACT  > struct EpiBf16 {
    static constexpr bool PERM = true, AFTER_DRAIN = false; static_assert(ACT == 0 || ACT == 1, "EpiBf16: ACT is 0 (none) or 1 (gelu_pk)");
    bf16_t* O; int ldc; const float* bias; int split_cols; size_t split_stride; float scale0;
    __device__ __forceinline__ void operator()(const f32x4 (&acc)[2][2][4][2], const Unit& u, int wr, int wc, int fr, int fq) const {
        const int row0 = u.pm * BM + wr * 64 + fr; int colt = u.pn * BM; bf16_t* base = O;
        float sc = 1.f; if (split_cols) { const int t = colt / split_cols; base += (size_t)t * split_stride; colt -= t * split_cols; if (t == 0) sc = scale0; }
        const int col0 = colt + wc * 32 + 8 * fq, bcol0 = u.pn * BM + wc * 32 + 8 * fq;
        f32x4 bv[2][2];
#pragma unroll
        for (int bj = 0; bj < 2; ++bj)
#pragma unroll
            for (int n = 0; n < 2; ++n) bv[bj][n] = bias ? *(const f32x4*)(bias + bcol0 + bj * HALF + 4 * n) : (f32x4){0.f, 0.f, 0.f, 0.f};
#pragma unroll
        for (int ai = 0; ai < 2; ++ai)
#pragma unroll
            for (int m = 0; m < 4; ++m) { bf16_t* rowp = base + (size_t)(row0 + ai * HALF + m * 16) * ldc + col0;
#pragma unroll
                for (int bj = 0; bj < 2; ++bj) { f32x4 v0 = acc[ai][bj][m][0] + bv[bj][0], v1 = acc[ai][bj][m][1] + bv[bj][1];
                    if (ACT == 1) { f32x2 a = gelu_pk((f32x2){v0[0], v0[1]}), b = gelu_pk((f32x2){v0[2], v0[3]}), c = gelu_pk((f32x2){v1[0], v1[1]}), d = gelu_pk((f32x2){v1[2], v1[3]});
                        v0 = (f32x4){a.x, a.y, b.x, b.y}; v1 = (f32x4){c.x, c.y, d.x, d.y}; }
                    v0 = v0 * sc; v1 = v1 * sc; u32x4 w; w.x = cvt_pk_bf16(v0[0], v0[1]); w.y = cvt_pk_bf16(v0[2], v0[3]); w.z = cvt_pk_bf16(v1[0], v1[1]); w.w = cvt_pk_bf16(v1[2], v1[3]);
                    *(u32x4*)(rowp + bj * HALF) = w; } }
    }
};

struct PanelStats {
    unsigned* xbuf;
    unsigned* cnt;
    unsigned* tmo;
    int ntn; float eps;
    unsigned code;
    __device__ __forceinline__ bool run(const f32x4 (&v)[2][2][4][2], const Unit& u, int wr, int wc, int fr, int fq, PG8_LAS unsigned char* lds, int wid, int lane) const {
        typedef float f32x2v __attribute__((ext_vector_type(2)));
        PG8_LAS f32x2v* P = (PG8_LAS f32x2v*)lds;
        PG8_LAS f32x2v* S = (PG8_LAS f32x2v*)(lds + 8192);
        PG8_LAS unsigned* flag = (PG8_LAS unsigned*)(lds + 8192 + 2048);
#pragma unroll
        for (int ai = 0; ai < 2; ++ai)
#pragma unroll
            for (int m = 0; m < 4; ++m) {
                float s = 0.f;
#pragma unroll
                for (int bj = 0; bj < 2; ++bj)
#pragma unroll
                    for (int n = 0; n < 2; ++n) { const f32x4 x = v[ai][bj][m][n]; s += (x[0] + x[1]) + (x[2] + x[3]); }
                s += __shfl_xor(s, 16); s += __shfl_xor(s, 32);
                const float mw = s * (1.0f / 64.0f); float q = 0.f;
#pragma unroll
                for (int bj = 0; bj < 2; ++bj)
#pragma unroll
                    for (int n = 0; n < 2; ++n) { const f32x4 d = v[ai][bj][m][n] - mw; q += (d[0] * d[0] + d[1] * d[1]) + (d[2] * d[2] + d[3] * d[3]); }
                q += __shfl_xor(q, 16); q += __shfl_xor(q, 32);
                if (fq == 0) P[(ai * HALF + wr * 64 + m * 16 + fr) * 4 + wc] = (f32x2v){mw, q};
            }
        asm volatile("s_waitcnt lgkmcnt(0)" ::: "memory"); __builtin_amdgcn_s_barrier(); asm volatile("" ::: "memory");
#if defined(BROKEN_EXCHANGE_NO_WAIT)
#warning BROKEN CONTROL BUILD: the row-statistics exchange does not wait; results are wrong by design
        if (blockIdx.x >= 64) { const long long t0_ = clock64(); while (clock64() - t0_ < 60000) __builtin_amdgcn_s_sleep(8); }
#endif
        const int row = wid * 32 + (lane & 31);
        if (lane < 32) {
            const f32x2v a = P[row * 4 + 0], b = P[row * 4 + 1], c = P[row * 4 + 2], d = P[row * 4 + 3];
            const float mt = (a.x + b.x + c.x + d.x) * 0.25f;
            const float da = a.x - mt, db = b.x - mt, dc = c.x - mt, dd = d.x - mt;
            const float m2 = (a.y + b.y) + (c.y + d.y) + 64.0f * ((da * da + db * db) + (dc * dc + dd * dd));
            unsigned long long* slot = (unsigned long long*)xbuf + ((size_t)(u.pm * BM + row) * 4 + u.pn);
            __hip_atomic_store(slot, ((unsigned long long)__float_as_uint(m2) << 32) | __float_as_uint(mt), __ATOMIC_RELAXED, __HIP_MEMORY_SCOPE_AGENT);
        }
        asm volatile("s_waitcnt vmcnt(0)" ::: "memory");
        if (lane == 0) __hip_atomic_fetch_add(cnt + 64 * u.pm, 1u, __ATOMIC_RELAXED, __HIP_MEMORY_SCOPE_AGENT);
        if (wid == 0) {
            bool dead = false; const unsigned long long t0 = __builtin_amdgcn_s_memrealtime(); const unsigned want = 8u * (unsigned)ntn;
            for (;;) {
#if defined(BROKEN_EXCHANGE_NO_WAIT)
                break;
#endif
                if ((unsigned)__builtin_amdgcn_readfirstlane(__hip_atomic_load(cnt + 64 * u.pm, __ATOMIC_RELAXED, __HIP_MEMORY_SCOPE_AGENT)) >= want) break;
                if (__builtin_amdgcn_s_memrealtime() - t0 > 2000000ull) {
                    if (lane == 0) { unsigned expect = 0u; __hip_atomic_compare_exchange_strong(tmo + 1, &expect, code | (unsigned)(u.pm & 0xff), __ATOMIC_RELAXED, __ATOMIC_RELAXED, __HIP_MEMORY_SCOPE_AGENT);
                                     __hip_atomic_store(tmo, 1u, __ATOMIC_RELAXED, __HIP_MEMORY_SCOPE_AGENT); }
                    dead = true; break; }
                __builtin_amdgcn_s_sleep(2);
            }
            __builtin_amdgcn_fence(__ATOMIC_ACQUIRE, "agent");
            if (lane == 0) flag[0] = dead ? 1u : 0u;
        }
        asm volatile("s_waitcnt vmcnt(0) lgkmcnt(0)" ::: "memory"); __builtin_amdgcn_s_barrier(); asm volatile("" ::: "memory");
        const bool bad = flag[0] != 0u;
        if (lane < 32) {
            const unsigned long long* slot = (const unsigned long long*)xbuf + (size_t)(u.pm * BM + row) * 4; float mt[4], m2[4]; float ms = 0.f;
#pragma unroll
            for (int t = 0; t < 4; ++t) { if (t < ntn) { const unsigned long long w = __hip_atomic_load(slot + t, __ATOMIC_RELAXED, __HIP_MEMORY_SCOPE_AGENT); mt[t] = __uint_as_float((unsigned)w); m2[t] = __uint_as_float((unsigned)(w >> 32)); } else { mt[t] = 0.f; m2[t] = 0.f; } ms += mt[t]; }
            const float mean = ms / (float)ntn; float q = 0.f;
#pragma unroll
            for (int t = 0; t < 4; ++t) if (t < ntn) { const float dm = mt[t] - mean; q += m2[t] + 256.0f * dm * dm; }
            S[row] = (f32x2v){mean, 1.0f / sqrtf(q / (256.0f * (float)ntn) + eps)};
        }
        asm volatile("s_waitcnt lgkmcnt(0)" ::: "memory"); __builtin_amdgcn_s_barrier(); asm volatile("" ::: "memory");
        return bad;
    }
};
struct EpiLnRes {
    static constexpr bool PERM = false, AFTER_DRAIN = true;
    const float* base; float* out; int ldc; const float* bias; PanelStats st; unsigned poison;
    __device__ __forceinline__ void fused(f32x4 (&acc)[2][2][4][2], const Unit& u, int wr, int wc, int fr, int fq, PG8_LAS unsigned char* lds, int wid, int lane) const {
        typedef float f32x2v __attribute__((ext_vector_type(2)));
        const PG8_LAS f32x2v* S = (const PG8_LAS f32x2v*)(lds + 8192);
        const int col0 = u.pn * BM + wc * 32 + 4 * fq;
#pragma unroll
        for (int bj = 0; bj < 2; ++bj)
#pragma unroll
            for (int n = 0; n < 2; ++n) { const f32x4 bv = bias ? *(const f32x4*)(bias + col0 + bj * HALF + n * 16) : (f32x4){0.f, 0.f, 0.f, 0.f};
#pragma unroll
                for (int ai = 0; ai < 2; ++ai)
#pragma unroll
                    for (int m = 0; m < 4; ++m) acc[ai][bj][m][n] += bv; }
        f32x4 pre[4][2][2];
#pragma unroll
        for (int m = 0; m < 4; ++m) { const size_t off = (size_t)(u.pm * BM + wr * 64 + m * 16 + fr) * ldc + col0;
#pragma unroll
            for (int bj = 0; bj < 2; ++bj)
#pragma unroll
                for (int n = 0; n < 2; ++n) pre[m][bj][n] = *(const f32x4*)(base + off + bj * HALF + n * 16); }
        const bool bad = st.run(acc, u, wr, wc, fr, fq, lds, wid, lane) || poison != 0u;
        const float qnan = __builtin_nanf("");
#pragma unroll
        for (int ai = 0; ai < 2; ++ai)
#pragma unroll
            for (int m = 0; m < 4; ++m) { const int r = ai * HALF + wr * 64 + m * 16 + fr; const f32x2v sr = S[r]; const size_t off = (size_t)(u.pm * BM + r) * ldc + col0;
#pragma unroll
                for (int bj = 0; bj < 2; ++bj)
#pragma unroll
                    for (int n = 0; n < 2; ++n) { const f32x4 bs = ai == 0 ? pre[m][bj][n] : *(const f32x4*)(base + off + bj * HALF + n * 16); f32x4 o = bs + (acc[ai][bj][m][n] - sr.x) * sr.y;
                        if (bad) o = (f32x4){qnan, qnan, qnan, qnan}; *(f32x4*)(out + off + bj * HALF + n * 16) = o; }
                if (m & 1) asm volatile("" ::: "memory"); }
    }
};
struct EpiLnResLn {
    static constexpr bool PERM = false, AFTER_DRAIN = true;
    const float* base; float* out; bf16_t* xn; int ldc; const float* bias; PanelStats st1, st2; unsigned poison;
    __device__ __forceinline__ void fused(f32x4 (&acc)[2][2][4][2], const Unit& u, int wr, int wc, int fr, int fq, PG8_LAS unsigned char* lds, int wid, int lane) const {
        typedef float f32x2v __attribute__((ext_vector_type(2))); typedef unsigned u32x2v __attribute__((ext_vector_type(2)));
        const PG8_LAS f32x2v* S = (const PG8_LAS f32x2v*)(lds + 8192);
        const int col0 = u.pn * BM + wc * 32 + 4 * fq;
#pragma unroll
        for (int bj = 0; bj < 2; ++bj)
#pragma unroll
            for (int n = 0; n < 2; ++n) { const f32x4 bv = bias ? *(const f32x4*)(bias + col0 + bj * HALF + n * 16) : (f32x4){0.f, 0.f, 0.f, 0.f};
#pragma unroll
                for (int ai = 0; ai < 2; ++ai)
#pragma unroll
                    for (int m = 0; m < 4; ++m) acc[ai][bj][m][n] += bv; }
        bool bad = st1.run(acc, u, wr, wc, fr, fq, lds, wid, lane) || poison != 0u;
        const float qnan = __builtin_nanf("");
#pragma unroll
        for (int ai = 0; ai < 2; ++ai)
#pragma unroll
            for (int m = 0; m < 4; ++m) { const int r = ai * HALF + wr * 64 + m * 16 + fr; const f32x2v sr = S[r]; const size_t off = (size_t)(u.pm * BM + r) * ldc + col0;
#pragma unroll
                for (int bj = 0; bj < 2; ++bj)
#pragma unroll
                    for (int n = 0; n < 2; ++n) { const f32x4 bs = *(const f32x4*)(base + off + bj * HALF + n * 16); acc[ai][bj][m][n] = bs + (acc[ai][bj][m][n] - sr.x) * sr.y; }
                asm volatile("" : "+v"(acc[ai][0][m][0]), "+v"(acc[ai][0][m][1]), "+v"(acc[ai][1][m][0]), "+v"(acc[ai][1][m][1]));
                if (m & 1) asm volatile("" ::: "memory"); }
        const bool bad1 = bad;
        bad = st2.run(acc, u, wr, wc, fr, fq, lds, wid, lane) || bad;
#pragma unroll
        for (int ai = 0; ai < 2; ++ai)
#pragma unroll
            for (int m = 0; m < 4; ++m) { const int r = ai * HALF + wr * 64 + m * 16 + fr; const f32x2v sr = S[r]; const size_t off = (size_t)(u.pm * BM + r) * ldc + col0;
#pragma unroll
                for (int bj = 0; bj < 2; ++bj)
#pragma unroll
                    for (int n = 0; n < 2; ++n) { const f32x4 x1 = acc[ai][bj][m][n]; *(f32x4*)(out + off + bj * HALF + n * 16) = bad1 ? (f32x4){qnan, qnan, qnan, qnan} : x1;
                        const f32x4 o = (x1 - sr.x) * sr.y; u32x2v w; w.x = cvt_pk_bf16(o[0], o[1]); w.y = cvt_pk_bf16(o[2], o[3]);
                        if (bad) { w.x = 0x7fc07fc0u; w.y = 0x7fc07fc0u; } *(u32x2v*)(xn + off + bj * HALF + n * 16) = w; }
                asm volatile("" ::: "memory"); }
    }
};

template <class Epi, class Sched, bool ALIGN_EPI = false, bool SP2 = false>
__device__ __forceinline__ void gemm_phase(PG8_LAS unsigned char* lds, const Gemm g, const Sched& S, const Epi& E) {
    const int tid = threadIdx.x, wid = __builtin_amdgcn_readfirstlane(tid >> 6), lane = tid & 63, wr = wid >> 2, wc = wid & 3, fr = lane & 15, fq = lane >> 4;
    const int K = g.K, nt = K / BK;
    unsigned voffA[2], voffB[2];
#pragma unroll
    for (int i = 0; i < 2; ++i) { int R, C; stage_rc(tid * 16 + i * 8192, R, C); const int Rb = Epi::PERM ? ((R & ~31) + perm32(R & 31)) : R;
        voffA[i] = (unsigned)(R * K + C) * 2u; voffB[i] = (unsigned)(Rb * K + C) * 2u; }
    const size_t kstep = (size_t)(BK * 2);
    const size_t hstep = (size_t)HALF * K * 2;
    const size_t tstep = 2 * hstep;
    const unsigned ldsw = (unsigned)wid * 1024u;
    const int aoff = lds_byte(wr * 64 + fr, fq * 8), boff = lds_byte(wc * 32 + fr, fq * 8);
#define PG8_SA(b, h) (((b) * 2 + (h)) * HTB)
#define PG8_SB(b, h) ((4 + (b) * 2 + (h)) * HTB)
#define PG8_STAGE(bufoff, gbase, voff) do { _Pragma("unroll") for (int _i = 0; _i < 2; ++_i) \
        __builtin_amdgcn_global_load_lds((const unsigned*)((const char*)(gbase) + (voff)[_i]), (PG8_LAS unsigned*)(lds + (bufoff) + ldsw + _i * 8192), 16, 0, 0); } while (0)
#define PG8_LDA(dst, b, h) do { _Pragma("unroll") for (int m = 0; m < 4; ++m) _Pragma("unroll") for (int k = 0; k < 2; ++k) dst[m][k] = *(const PG8_LAS bf16x8*)(lds + PG8_SA(b, h) + aoff + m * 2048 + k * 1024); } while (0)
#define PG8_LDB(dst, b, h) do { _Pragma("unroll") for (int n = 0; n < 2; ++n) _Pragma("unroll") for (int k = 0; k < 2; ++k) dst[n][k] = *(const PG8_LAS bf16x8*)(lds + PG8_SB(b, h) + boff + n * 2048 + k * 1024); } while (0)
#define PG8_MMA(ai, bj, At, Bt) do { __builtin_amdgcn_s_setprio(1); _Pragma("unroll") for (int m = 0; m < 4; ++m) _Pragma("unroll") for (int n = 0; n < 2; ++n) _Pragma("unroll") for (int k = 0; k < 2; ++k) \
        acc[ai][bj][m][n] = __builtin_amdgcn_mfma_f32_16x16x32_bf16(Bt[n][k], At[m][k], acc[ai][bj][m][n], 0, 0, 0); __builtin_amdgcn_s_setprio(0); } while (0)
#define PG8_WAIT_V(n) asm volatile("s_waitcnt vmcnt(" #n ")" ::: "memory")
#define PG8_WAIT_L(n) asm volatile("s_waitcnt lgkmcnt(" #n ")" ::: "memory")
#define PG8_BAR __builtin_amdgcn_s_barrier()
#define PG8_SCHED __builtin_amdgcn_sched_barrier(0)
    Unit cur, nxt; int ui = 0;
    if (!S.next(0, cur)) return;
    f32x4 acc[2][2][4][2];
#pragma unroll
    for (int a = 0; a < 2; ++a)
#pragma unroll
        for (int b = 0; b < 2; ++b)
#pragma unroll
            for (int m = 0; m < 4; ++m)
#pragma unroll
                for (int n = 0; n < 2; ++n) acc[a][b][m][n] = (f32x4){0.f, 0.f, 0.f, 0.f};
    bf16x8 At[4][2], B0[2][2], B1[2][2];
    const char* cA = (const char*)g.A + (size_t)cur.pm * tstep; const char* cB = (const char*)g.Bt + (size_t)cur.pn * tstep;
    S.a_ready(cur);
    if constexpr (SP2) {
        PG8_STAGE(PG8_SB(0, 0), cB, voffB); PG8_STAGE(PG8_SB(0, 1), cB + hstep, voffB); PG8_STAGE(PG8_SA(0, 0), cA, voffA); PG8_STAGE(PG8_SA(0, 1), cA + hstep, voffA);
        if (wr == 1) PG8_BAR;
        PG8_WAIT_V(2); PG8_BAR;
        PG8_STAGE(PG8_SB(1, 0), cB + kstep, voffB); PG8_STAGE(PG8_SA(1, 0), cA + kstep, voffA); PG8_STAGE(PG8_SB(1, 1), cB + hstep + kstep, voffB);
        PG8_WAIT_V(6); PG8_BAR;
    } else {
        PG8_STAGE(PG8_SB(0, 0), cB, voffB); PG8_STAGE(PG8_SA(0, 0), cA, voffA); PG8_STAGE(PG8_SB(0, 1), cB + hstep, voffB); PG8_STAGE(PG8_SA(0, 1), cA + hstep, voffA);
        if (wr == 1) PG8_BAR;
        PG8_WAIT_V(4); PG8_BAR;
        PG8_STAGE(PG8_SB(1, 0), cB + kstep, voffB); PG8_STAGE(PG8_SA(1, 0), cA + kstep, voffA); PG8_STAGE(PG8_SB(1, 1), cB + hstep + kstep, voffB);
        PG8_WAIT_V(6); PG8_BAR;
    }
    for (;;) {
        const bool has_next = S.next(ui + 1, nxt);
        const char* nA = has_next ? (const char*)g.A + (size_t)nxt.pm * tstep : cA; const char* nB = has_next ? (const char*)g.Bt + (size_t)nxt.pn * tstep : cB;
        for (int t = 0; t < nt; t += 2) {
            const bool last = (t == nt - 2);
            const char* a1 = cA + (size_t)(t + 1) * kstep;
            const char* a2 = last ? nA : cA + (size_t)(t + 2) * kstep; const char* b2 = last ? nB : cB + (size_t)(t + 2) * kstep;
            const char* a3 = a2 + kstep; const char* b3 = b2 + kstep;
            if (last && has_next) S.a_ready(nxt);
            if constexpr (SP2) {
            PG8_LDB(B0, 0, 0); PG8_LDB(B1, 0, 1); PG8_SCHED; PG8_LDA(At, 0, 0); PG8_STAGE(PG8_SA(1, 1), a1 + hstep, voffA);
            PG8_WAIT_V(8); PG8_WAIT_L(0); PG8_BAR; PG8_MMA(0, 0, At, B0); PG8_MMA(0, 1, At, B1); PG8_BAR; PG8_SCHED;
            PG8_LDA(At, 0, 1); PG8_STAGE(PG8_SB(0, 0), b2, voffB); PG8_STAGE(PG8_SB(0, 1), b2 + hstep, voffB); PG8_STAGE(PG8_SA(0, 0), a2, voffA);
            PG8_WAIT_V(8); PG8_WAIT_L(0); PG8_BAR; PG8_MMA(1, 0, At, B0); PG8_MMA(1, 1, At, B1); PG8_BAR; PG8_SCHED;
            PG8_LDB(B0, 1, 0); PG8_LDB(B1, 1, 1); PG8_SCHED; PG8_LDA(At, 1, 0); PG8_STAGE(PG8_SA(0, 1), a2 + hstep, voffA);
            PG8_WAIT_V(8); PG8_WAIT_L(0); PG8_BAR; PG8_MMA(0, 0, At, B0); PG8_MMA(0, 1, At, B1); PG8_BAR; PG8_SCHED;
            PG8_LDA(At, 1, 1); PG8_STAGE(PG8_SB(1, 0), b3, voffB); PG8_STAGE(PG8_SB(1, 1), b3 + hstep, voffB); PG8_STAGE(PG8_SA(1, 0), a3, voffA);
            PG8_WAIT_V(8); PG8_WAIT_L(0); PG8_BAR; PG8_MMA(1, 0, At, B0); PG8_MMA(1, 1, At, B1); PG8_BAR; PG8_SCHED;
            } else {
            PG8_LDB(B0, 0, 0); PG8_SCHED; PG8_LDA(At, 0, 0); PG8_STAGE(PG8_SA(1, 1), a1 + hstep, voffA);
            PG8_WAIT_L(8); PG8_BAR; PG8_WAIT_L(0); PG8_MMA(0, 0, At, B0); PG8_BAR; PG8_SCHED;
            PG8_LDB(B1, 0, 1); PG8_STAGE(PG8_SB(0, 0), b2, voffB);
            PG8_BAR; PG8_WAIT_L(0); PG8_MMA(0, 1, At, B1); PG8_BAR;
            PG8_LDA(At, 0, 1); PG8_STAGE(PG8_SA(0, 0), a2, voffA);
            PG8_BAR; PG8_WAIT_L(0); PG8_MMA(1, 0, At, B0); PG8_BAR; PG8_SCHED;
            PG8_STAGE(PG8_SB(0, 1), b2 + hstep, voffB);
            PG8_WAIT_V(6); PG8_BAR; PG8_MMA(1, 1, At, B1); PG8_BAR;
            PG8_LDB(B0, 1, 0); PG8_SCHED; PG8_LDA(At, 1, 0); PG8_STAGE(PG8_SA(0, 1), a2 + hstep, voffA);
            PG8_WAIT_L(8); PG8_BAR; PG8_WAIT_L(0); PG8_MMA(0, 0, At, B0); PG8_BAR; PG8_SCHED;
            PG8_LDB(B1, 1, 1); PG8_STAGE(PG8_SB(1, 0), b3, voffB);
            PG8_BAR; PG8_WAIT_L(0); PG8_MMA(0, 1, At, B1); PG8_BAR;
            PG8_LDA(At, 1, 1); PG8_STAGE(PG8_SA(1, 0), a3, voffA);
            PG8_BAR; PG8_WAIT_L(0); PG8_MMA(1, 0, At, B0); PG8_BAR; PG8_SCHED;
            PG8_STAGE(PG8_SB(1, 1), b3 + hstep, voffB);
            PG8_WAIT_V(6); PG8_BAR; PG8_MMA(1, 1, At, B1); PG8_BAR;
            }
        }
        if constexpr (ALIGN_EPI) { if (wr == 0) PG8_BAR; }
        if constexpr (!Epi::AFTER_DRAIN) { E(acc, cur, wr, wc, fr, fq); S.done(cur); }
        if (!has_next) break;
#pragma unroll
        for (int a = 0; a < 2; ++a)
#pragma unroll
            for (int b = 0; b < 2; ++b)
#pragma unroll
                for (int m = 0; m < 4; ++m)
#pragma unroll
                    for (int n = 0; n < 2; ++n) acc[a][b][m][n] = (f32x4){0.f, 0.f, 0.f, 0.f};
        cur = nxt; cA = nA; cB = nB; ++ui;
        if constexpr (ALIGN_EPI) { if (wr == 1) PG8_BAR; }
    }
    PG8_WAIT_V(0);
    if constexpr (!ALIGN_EPI) { if (wr == 0) PG8_BAR; }
    PG8_BAR;
    if constexpr (Epi::AFTER_DRAIN) { E.fused(acc, cur, wr, wc, fr, fq, lds, wid, lane); S.done(cur); }
#undef PG8_SA
#undef PG8_SB
#undef PG8_STAGE
#undef PG8_LDA
#undef PG8_LDB
#undef PG8_MMA
#undef PG8_WAIT_V
#undef PG8_WAIT_L
#undef PG8_BAR
#undef PG8_SCHED
}
}

namespace pg8 {
constexpr float RMS_EPS = 1e-6f;
__device__ __forceinline__ float row_rstd(const float* ss, int row) {
    const f32x4* p = (const f32x4*)(ss + (size_t)row * 16); const f32x4 a = p[0], b = p[1], c = p[2], d = p[3];
    const float s = (((a[0] + a[1]) + (a[2] + a[3])) + ((b[0] + b[1]) + (b[2] + b[3]))) + (((c[0] + c[1]) + (c[2] + c[3])) + ((d[0] + d[1]) + (d[2] + d[3])));
    return 1.0f / sqrtf(s * (1.0f / 1024.0f) + RMS_EPS);
}
__device__ __forceinline__ float silu_f(float g) { return g * __builtin_amdgcn_rcpf(1.0f + __builtin_amdgcn_exp2f(-1.4426950408889634f * g)); }
struct EpiSwiGLU {
    static constexpr bool PERM = true, AFTER_DRAIN = false;
    bf16_t* H; int ldh; const float* ss;
    __device__ __forceinline__ void operator()(const f32x4 (&acc)[2][2][4][2], const Unit& u, int wr, int wc, int fr, int fq) const {
        const int row0 = u.pm * BM + wr * 64 + fr, col0 = u.pn * 128 + wc * 32 + 8 * fq;
#pragma unroll
        for (int ai = 0; ai < 2; ++ai)
#pragma unroll
            for (int m = 0; m < 4; ++m) { const int row = row0 + ai * HALF + m * 16; const float rs = row_rstd(ss, row);
                float h[8];
#pragma unroll
                for (int n = 0; n < 2; ++n)
#pragma unroll
                    for (int e = 0; e < 4; ++e) { const float g = acc[ai][0][m][n][e] * rs, up = acc[ai][1][m][n][e] * rs; h[n * 4 + e] = silu_f(g) * up; }
                u32x4 w; w.x = cvt_pk_bf16(h[0], h[1]); w.y = cvt_pk_bf16(h[2], h[3]); w.z = cvt_pk_bf16(h[4], h[5]); w.w = cvt_pk_bf16(h[6], h[7]);
                *(u32x4*)(H + (size_t)row * ldh + col0) = w; }
    }
};
struct EpiProj {
    static constexpr bool PERM = true, AFTER_DRAIN = false;
    bf16_t* PA; bf16_t* PR; const float* ss;
    __device__ __forceinline__ void operator()(const f32x4 (&acc)[2][2][4][2], const Unit& u, int wr, int wc, int fr, int fq) const {
        const int row0 = u.pm * BM + wr * 64 + fr; const int cin = wc * 32 + 8 * fq;
        bf16_t* base; int ld;
        if (u.pn < 4) { base = PA + u.pn * 256 + cin; ld = 1024; } else { base = PR + (u.pn - 4) * 256 + cin; ld = 2560; }
#pragma unroll
        for (int ai = 0; ai < 2; ++ai)
#pragma unroll
            for (int m = 0; m < 4; ++m) { const int row = row0 + ai * HALF + m * 16; const float rs = row_rstd(ss, row);
#pragma unroll
                for (int bj = 0; bj < 2; ++bj) { const f32x4 v0 = acc[ai][bj][m][0] * rs, v1 = acc[ai][bj][m][1] * rs;
                    u32x4 w; w.x = cvt_pk_bf16(v0[0], v0[1]); w.y = cvt_pk_bf16(v0[2], v0[3]); w.z = cvt_pk_bf16(v1[0], v1[1]); w.w = cvt_pk_bf16(v1[2], v1[3]);
                    *(u32x4*)(base + (size_t)row * ld + bj * HALF) = w; } }
    }
};
struct EpiResid {
    static constexpr bool PERM = true, AFTER_DRAIN = false;
    const float* base; float* out; bf16_t* xb; float* ss; float scale;
    __device__ __forceinline__ void operator()(const f32x4 (&acc)[2][2][4][2], const Unit& u, int wr, int wc, int fr, int fq) const {
        const int row0 = u.pm * BM + wr * 64 + fr, col0 = u.pn * BM + wc * 32 + 8 * fq;
#pragma unroll
        for (int ai = 0; ai < 2; ++ai)
#pragma unroll
            for (int m = 0; m < 4; ++m) { const int row = row0 + ai * HALF + m * 16; const size_t off = (size_t)row * 1024 + col0; float sq = 0.f;
#pragma unroll
                for (int bj = 0; bj < 2; ++bj) {
                    const f32x4 b0 = *(const f32x4*)(base + off + bj * HALF), b1 = *(const f32x4*)(base + off + bj * HALF + 4);
                    const f32x4 v0 = b0 + acc[ai][bj][m][0] * scale, v1 = b1 + acc[ai][bj][m][1] * scale;
                    *(f32x4*)(out + off + bj * HALF) = v0; *(f32x4*)(out + off + bj * HALF + 4) = v1;
                    sq += ((v0[0] * v0[0] + v0[1] * v0[1]) + (v0[2] * v0[2] + v0[3] * v0[3])) + ((v1[0] * v1[0] + v1[1] * v1[1]) + (v1[2] * v1[2] + v1[3] * v1[3]));
                    if (xb) { u32x4 w; w.x = cvt_pk_bf16(v0[0], v0[1]); w.y = cvt_pk_bf16(v0[2], v0[3]); w.z = cvt_pk_bf16(v1[0], v1[1]); w.w = cvt_pk_bf16(v1[2], v1[3]);
                        *(u32x4*)(xb + off + bj * HALF) = w; } }
                if (ss) { sq += __shfl_xor(sq, 16); sq += __shfl_xor(sq, 32); if (fq == 0) ss[(size_t)row * 16 + u.pn * 4 + wc] = sq; } }
    }
};
}

namespace att {
using bf16 = __hip_bfloat16;
constexpr int   D = 128, NW = 8, QBLK = 32, KVBLK = 64;
constexpr float SCALE = 0.088388347648318440f;
constexpr float THR = 8.f;
constexpr int SDEPTH = 2;
constexpr int LDQ = 1024, LDK = 1024, LDO = 512;
constexpr size_t SHM_V = KVBLK * D * 2, SHM_K = KVBLK * D * 2, SHM_ATTN = 2 * SHM_V + 2 * SHM_K + NW * 64 * 4;
using bf16x8 = __attribute__((ext_vector_type(8))) short;
using s16x4  = __attribute__((ext_vector_type(4))) short;
using f32x16 = __attribute__((ext_vector_type(16))) float;
using f32x8  = __attribute__((ext_vector_type(8))) float;
using u32x4  = __attribute__((ext_vector_type(4))) unsigned;
#define KSWZ(row, colB) ((row) * 256 + ((colB) ^ (((row) & 7) << 4)))
#define SBAR() __builtin_amdgcn_sched_barrier(0)
__device__ __forceinline__ int crow(int r, int hi) { return (r & 3) + 8 * (r >> 2) + 4 * hi; }
__device__ __forceinline__ unsigned cvtpk(float lo, float hi) {
  unsigned r; asm volatile("v_cvt_pk_bf16_f32 %0, %1, %2" : "=v"(r) : "v"(lo), "v"(hi)); return r;
}
template <typename TIn> struct Stage;
template <> struct Stage<bf16>  { using T = bf16x8;
  __device__ static __forceinline__ T ld8(const bf16* p) { return *reinterpret_cast<const bf16x8*>(p); }
  __device__ static __forceinline__ bf16x8 tobf(T x) { return x; } };
template <> struct Stage<float> { using T = f32x8;
  __device__ static __forceinline__ T ld8(const float* p) { return *reinterpret_cast<const f32x8*>(p); }
  __device__ static __forceinline__ bf16x8 tobf(T x) {
    u32x4 w = {cvtpk(x[0], x[1]), cvtpk(x[2], x[3]), cvtpk(x[4], x[5]), cvtpk(x[6], x[7])}; return *reinterpret_cast<bf16x8*>(&w); } };

__device__ __forceinline__ void partialSM(f32x16& p0, f32x16& p1, float& m_reg, float& mn, float& alpha) {
  constexpr float C = SCALE * 1.4426950408889634f;
  float pmax = p0[0]; for (int r = 1; r < 16; ++r) pmax = fmaxf(pmax, p0[r]); for (int r = 0; r < 16; ++r) pmax = fmaxf(pmax, p1[r]);
  { auto rr = __builtin_amdgcn_permlane32_swap(__float_as_uint(pmax), __float_as_uint(pmax), false, false);
    pmax = fmaxf(__uint_as_float(rr[0]), __uint_as_float(rr[1])); }
  if (__builtin_expect(__all(pmax - m_reg <= THR / SCALE), 1)) { mn = m_reg; alpha = 1.f; }
  else { mn = fmaxf(m_reg, pmax); alpha = __builtin_amdgcn_exp2f((m_reg - mn) * C); m_reg = mn; }
  float mnC = -mn * C;
  for (int r = 0; r < 16; ++r) p0[r] = fmaf(p0[r], C, mnC); for (int r = 0; r < 16; ++r) p1[r] = fmaf(p1[r], C, mnC);
  for (int r = 0; r < 16; ++r) p0[r] = __builtin_amdgcn_exp2f(p0[r]);
}
__device__ __forceinline__ void finishSM(f32x16& p0, f32x16& p1, float alpha, float& l_reg, bf16x8& pa0, bf16x8& pa1, bf16x8& pa2, bf16x8& pa3) {
  for (int r = 0; r < 16; ++r) p1[r] = __builtin_amdgcn_exp2f(p1[r]);
  float ps = 0; for (int r = 0; r < 16; ++r) ps += p0[r]; for (int r = 0; r < 16; ++r) ps += p1[r];
  { auto rr = __builtin_amdgcn_permlane32_swap(__float_as_uint(ps), __float_as_uint(ps), false, false);
    ps = __uint_as_float(rr[0]) + __uint_as_float(rr[1]); }
  l_reg = l_reg * alpha + ps;
#define PK4(P, BASE, OUT) do { unsigned a0 = cvtpk(P[BASE + 0], P[BASE + 1]), a1 = cvtpk(P[BASE + 2], P[BASE + 3]);   \
    unsigned b0 = cvtpk(P[BASE + 4], P[BASE + 5]), b1 = cvtpk(P[BASE + 6], P[BASE + 7]);                              \
    auto r0 = __builtin_amdgcn_permlane32_swap(a0, b0, false, false); auto r1 = __builtin_amdgcn_permlane32_swap(a1, b1, false, false); \
    u32x4 w = {r0[0], r1[0], r0[1], r1[1]}; OUT = *reinterpret_cast<bf16x8*>(&w); } while (0)
  PK4(p0, 0, pa0); PK4(p0, 8, pa1); PK4(p1, 0, pa2); PK4(p1, 8, pa3);
#undef PK4
}
__device__ __forceinline__ void qkt(f32x16& p0, f32x16& p1, const bf16* Ks, const bf16x8* qr, int r32, int hi) {
  p0 = f32x16{}; p1 = f32x16{};
  for (int d0 = 0; d0 < 8; ++d0) { int cb = (d0 * 16 + hi * 8) * 2;
    bf16x8 b0 = *reinterpret_cast<const bf16x8*>((const char*)Ks + KSWZ(r32, cb));
    bf16x8 b1 = *reinterpret_cast<const bf16x8*>((const char*)Ks + KSWZ(32 + r32, cb));
    p0 = __builtin_amdgcn_mfma_f32_32x32x16_bf16(b0, qr[d0], p0, 0, 0, 0);
    p1 = __builtin_amdgcn_mfma_f32_32x32x16_bf16(b1, qr[d0], p1, 0, 0, 0); }
}
__device__ __forceinline__ int v_st(int k, int c) { const int kk = (k & ~0xC) | ((k & 4) << 1) | ((k & 8) >> 1); return ((kk >> 3) * 4 + (c >> 5)) * 512 + ((kk & 7) * 32 + (c & 31)) * 2; }
__device__ __forceinline__ int v_rd_base(int lane) { return ((lane & 3) << 3) | (((lane >> 2) & 3) << 6) | (((lane >> 4) & 1) << 5) | (((lane >> 5) & 1) << 8); }
constexpr int v_rd_off(int d0, int ks, int half) { return d0 * 512 + ks * 4096 + half * 2048; }
template <int OFF> __device__ __forceinline__ s16x4 tr_read(int vb) {
  s16x4 r; asm volatile("ds_read_b64_tr_b16 %0, %1 offset:%2" : "=&v"(r) : "v"(vb), "i"(OFF) : "memory"); return r;
}
template <int D0> __device__ __forceinline__ void pv_one(f32x16& od, int vb, bf16x8 pa0, bf16x8 pa1, bf16x8 pa2, bf16x8 pa3) {
  const s16x4 l0 = tr_read<v_rd_off(D0, 0, 0)>(vb), h0 = tr_read<v_rd_off(D0, 0, 1)>(vb), l1 = tr_read<v_rd_off(D0, 1, 0)>(vb), h1 = tr_read<v_rd_off(D0, 1, 1)>(vb);
  const s16x4 l2 = tr_read<v_rd_off(D0, 2, 0)>(vb), h2 = tr_read<v_rd_off(D0, 2, 1)>(vb), l3 = tr_read<v_rd_off(D0, 3, 0)>(vb), h3 = tr_read<v_rd_off(D0, 3, 1)>(vb);
  asm volatile("s_waitcnt lgkmcnt(0)" ::: "memory"); SBAR();
#define PK(L, H) (bf16x8){L[0], L[1], L[2], L[3], H[0], H[1], H[2], H[3]}
  od = __builtin_amdgcn_mfma_f32_32x32x16_bf16(pa0, PK(l0, h0), od, 0, 0, 0);
  od = __builtin_amdgcn_mfma_f32_32x32x16_bf16(pa1, PK(l1, h1), od, 0, 0, 0);
  od = __builtin_amdgcn_mfma_f32_32x32x16_bf16(pa2, PK(l2, h2), od, 0, 0, 0);
  od = __builtin_amdgcn_mfma_f32_32x32x16_bf16(pa3, PK(l3, h3), od, 0, 0, 0);
#undef PK
}
__device__ __forceinline__ void pv_d0(f32x16* o, int vb, bf16x8 pa0, bf16x8 pa1, bf16x8 pa2, bf16x8 pa3) {
  pv_one<0>(o[0], vb, pa0, pa1, pa2, pa3); pv_one<1>(o[1], vb, pa0, pa1, pa2, pa3); pv_one<2>(o[2], vb, pa0, pa1, pa2, pa3); pv_one<3>(o[3], vb, pa0, pa1, pa2, pa3);
}

template <typename TQ>
__device__ __forceinline__ void attn_dense_body(const TQ* __restrict__ Qb, const bf16* __restrict__ Kh, const bf16* __restrict__ Vh,
                                                float* __restrict__ Ob, int seq, char* lds) {
  using St = Stage<bf16>; using SQ = Stage<TQ>;
  const int tid = threadIdx.x, wid = tid >> 6, lane = tid & 63, r32 = lane & 31, hi = lane >> 5;
  bf16* V_lds = (bf16*)lds; bf16* K_lds = (bf16*)(lds + 2 * SHM_V);
  float* ws = (float*)(lds + 2 * SHM_V + 2 * SHM_K) + wid * 64; float* li_l = ws; float* al_l = ws + 32;
  float m_reg = -1e30f, l_reg = 0; f32x16 o[4] = {}; bf16x8 qr[8];
  const TQ* Qw = Qb + (long)(wid * QBLK + r32) * LDQ + hi * 8;
#pragma unroll
  for (int d0 = 0; d0 < 8; ++d0) qr[d0] = SQ::tobf(SQ::ld8(Qw + d0 * 16));
  const int sr = tid >> 4, sc = (tid & 15) * 8, vst0 = v_st(sr, sc), vst1 = v_st(32 + sr, sc);
  const int vb0 = (int)(uintptr_t)V_lds + v_rd_base(lane);
  struct { typename St::T vs0, vs1, ks0, ks1; } sr_[SDEPTH];
#define SLOAD(i, k0) do { sr_[i].vs0 = St::ld8(&Vh[(long)((k0) + sr) * LDK + sc]); sr_[i].vs1 = St::ld8(&Vh[(long)((k0) + 32 + sr) * LDK + sc]); \
    sr_[i].ks0 = St::ld8(&Kh[(long)((k0) + sr) * LDK + sc]); sr_[i].ks1 = St::ld8(&Kh[(long)((k0) + 32 + sr) * LDK + sc]); } while (0)
#define SWRITE(b, i) do { *(bf16x8*)((char*)V_lds + (b) * SHM_V + vst0) = St::tobf(sr_[i].vs0);          \
    *(bf16x8*)((char*)V_lds + (b) * SHM_V + vst1) = St::tobf(sr_[i].vs1); int kc = sc * 2;               \
    *(bf16x8*)((char*)K_lds + (b) * SHM_K + KSWZ(sr, kc)) = St::tobf(sr_[i].ks0);                       \
    *(bf16x8*)((char*)K_lds + (b) * SHM_K + KSWZ(32 + sr, kc)) = St::tobf(sr_[i].ks1); } while (0)
#define SWAIT() do { if constexpr (SDEPTH == 2) asm volatile("s_waitcnt vmcnt(4)" ::: "memory"); else asm volatile("s_waitcnt vmcnt(0)" ::: "memory"); } while (0)
#define RESC(a) do { if (__any((a) < 1.f)) { if (hi == 0) al_l[r32] = (a); asm volatile("s_waitcnt lgkmcnt(0)" ::: "memory"); \
    for (int d = 0; d < 4; ++d) for (int r = 0; r < 16; ++r) o[d][r] *= al_l[crow(r, hi)]; } } while (0)
  f32x16 pA0, pA1, pB0, pB1; float mnA, mnB, alA, alB; bf16x8 pa0, pa1, pa2, pa3; const int NT = seq / KVBLK;
  constexpr int SE = 0, SO = SDEPTH - 1;
  SLOAD(SE, 0); asm volatile("s_waitcnt vmcnt(0)" ::: "memory"); SWRITE(0, SE); __syncthreads();
  qkt(pA0, pA1, K_lds, qr, r32, hi); partialSM(pA0, pA1, m_reg, mnA, alA);
  SLOAD(SO, KVBLK); if constexpr (SDEPTH == 2) { if (2 < NT) SLOAD(SE, 2 * KVBLK); }
  SWAIT(); SWRITE(1, SO); __syncthreads();
  for (int j = 1; j + 1 < NT; j += 2) {
    SBAR(); qkt(pB0, pB1, (bf16*)((char*)K_lds + SHM_K), qr, r32, hi);
    finishSM(pA0, pA1, alA, l_reg, pa0, pa1, pa2, pa3); SBAR();
    SLOAD(SO, (j + SDEPTH) * KVBLK); SBAR();
    pv_d0(o, vb0, pa0, pa1, pa2, pa3); partialSM(pB0, pB1, m_reg, mnB, alB);
    __syncthreads(); SWAIT(); SWRITE(0, SE);
    RESC(alB); __syncthreads();
    SBAR(); qkt(pA0, pA1, K_lds, qr, r32, hi);
    finishSM(pB0, pB1, alB, l_reg, pa0, pa1, pa2, pa3); SBAR();
    if (SDEPTH == 1 || j + 3 < NT) SLOAD(SE, (j + 1 + SDEPTH) * KVBLK); SBAR();
    pv_d0(o, vb0 + (int)SHM_V, pa0, pa1, pa2, pa3); partialSM(pA0, pA1, m_reg, mnA, alA);
    __syncthreads(); SWAIT(); SWRITE(1, SO);
    RESC(alA); __syncthreads();
  }
  SBAR(); qkt(pB0, pB1, (bf16*)((char*)K_lds + SHM_K), qr, r32, hi);
  finishSM(pA0, pA1, alA, l_reg, pa0, pa1, pa2, pa3); SBAR();
  pv_d0(o, vb0, pa0, pa1, pa2, pa3); partialSM(pB0, pB1, m_reg, mnB, alB);
  __syncthreads(); RESC(alB);
  finishSM(pB0, pB1, alB, l_reg, pa0, pa1, pa2, pa3); SBAR();
  pv_d0(o, vb0 + (int)SHM_V, pa0, pa1, pa2, pa3);
  if (hi == 0) li_l[r32] = l_reg; asm volatile("s_waitcnt lgkmcnt(0)" ::: "memory");
  float rli[16];
#pragma unroll
  for (int r = 0; r < 16; ++r) rli[r] = __builtin_amdgcn_rcpf(li_l[crow(r, hi)]);
  float* Ow = Ob + (long)(wid * QBLK) * LDO;
#pragma unroll
  for (int r = 0; r < 16; ++r) { int orow = crow(r, hi);
    for (int d0 = 0; d0 < 4; ++d0) Ow[(long)orow * LDO + d0 * 32 + r32] = o[d0][r] * rli[r]; }
#undef SLOAD
#undef SWRITE
#undef SWAIT
#undef RESC
}
}

namespace mk {
#define LAS __attribute__((address_space(3)))
typedef unsigned short bf16_t;
typedef short bf16x8 __attribute__((ext_vector_type(8)));
typedef float f32x4 __attribute__((ext_vector_type(4)));
typedef float f32x2 __attribute__((ext_vector_type(2)));
typedef float f32x16 __attribute__((ext_vector_type(16)));
typedef unsigned u32x4 __attribute__((ext_vector_type(4)));
typedef unsigned u32x2 __attribute__((ext_vector_type(2)));
constexpr int M = 16384, DM = 1024, T = 8192, FF = 2816, NIN = 3584, NTH = 512, NWAVES = 8;
constexpr int LDS_BYTES = 131072;
constexpr float EPS = 1e-6f, LOG2E = 1.4426950408889634f, LN2 = 0.6931471805599453f;
constexpr size_t WS_SSA = 0, WS_SSB = (size_t)1 << 20, WS_DC = (size_t)2 << 20, WS_ASS = (size_t)3 << 20, WS_W = (size_t)4 << 20;
constexpr size_t SZ_W1T = (size_t)2 * FF * DM * 2, SZ_W2T = (size_t)DM * FF * 2, SZ_WIN = (size_t)NIN * DM * 2, SZ_WO = (size_t)DM * DM * 2;
constexpr size_t WS_W1A = WS_W, WS_W2A = WS_W1A + SZ_W1T, WS_WIN = WS_W2A + SZ_W2T, WS_WO = WS_WIN + SZ_WIN, WS_W1B = WS_WO + SZ_WO, WS_W2B = WS_W1B + SZ_W1T;
constexpr size_t WS_X = WS_W2B + SZ_W2T;
constexpr size_t WS_B = WS_X + (size_t)M * DM * 2;
constexpr size_t WS_PR = WS_B + (size_t)M * 1024 * 2;
constexpr size_t WS_C = WS_B + (size_t)M * NIN * 2;
constexpr size_t WS_END = WS_C + (size_t)2048 * 16384 * 2;

__device__ __forceinline__ float bf_lo(unsigned u) { return __uint_as_float(u << 16); }
__device__ __forceinline__ float bf_hi(unsigned u) { return __uint_as_float(u & 0xffff0000u); }
__device__ __forceinline__ unsigned pk(float lo, float hi) { return pg8::cvt_pk_bf16(lo, hi); }
__device__ __forceinline__ float wave_sum(float v) {
#pragma unroll
    for (int o = 1; o < 64; o <<= 1) v += __shfl_xor(v, o);
    return v;
}
__device__ __forceinline__ float fexp(float x) { return __builtin_amdgcn_exp2f(x * LOG2E); }
__device__ __forceinline__ int crow(int r, int hi) { return (r & 3) + 8 * (r >> 2) + 4 * hi; }
#define LDSW() asm volatile("s_waitcnt lgkmcnt(0)" ::: "memory")

struct Args { const float* in[16]; float* out; unsigned char* ws; int lo, hi; };

__device__ __forceinline__ void tr_item(const float* W, int K, int N, bf16_t* WT, const float* gain, bool swiglu, LAS float* scr, int item, int lane) {
    const int nblk = N / 32, kb = item / nblk, nb = item % nblk, k0 = 64 * kb, n0 = 32 * nb;
    float wv[32];
#pragma unroll
    for (int i = 0; i < 32; ++i) wv[i] = W[(size_t)(k0 + 2 * i + (lane >> 5)) * N + n0 + (lane & 31)];
#pragma unroll
    for (int i = 0; i < 32; ++i) { const int kk = 2 * i + (lane >> 5); float v = wv[i]; if (gain) v *= gain[k0 + kk]; scr[kk * 33 + (lane & 31)] = v; }
    LDSW();
    int dst = n0;
    if (swiglu) { const int half = N / 2; dst = (n0 < half) ? (n0 / 128) * 256 + (n0 % 128) : ((n0 - half) / 128) * 256 + 128 + ((n0 - half) % 128); }
    const int c = lane & 7;
#pragma unroll
    for (int j = 0; j < 4; ++j) { const int n = (lane >> 3) + 8 * j; const LAS float* s = scr + (8 * c) * 33 + n;
        u32x4 o; o.x = pk(s[0 * 33], s[1 * 33]); o.y = pk(s[2 * 33], s[3 * 33]); o.z = pk(s[4 * 33], s[5 * 33]); o.w = pk(s[6 * 33], s[7 * 33]);
        *(u32x4*)(WT + (size_t)(dst + n) * K + k0 + 8 * c) = o; }
    LDSW();
}

__device__ __forceinline__ void rec_gates(const bf16_t* zp  , float lb0, float lb1, float (&g)[8][2], float (&kk)[8][2]) {
#pragma unroll
    for (int i = 0; i < 8; ++i) { const unsigned z = *(const unsigned*)(zp + (size_t)i * 2560);
        const float z0 = bf_lo(z), z1 = bf_hi(z);
        const float s0 = __builtin_amdgcn_rcpf(1.0f + fexp(-z0)), s1 = __builtin_amdgcn_rcpf(1.0f + fexp(-z1));
        const float f0 = lb0 + (1.0f - lb0) * s0, f1 = lb1 + (1.0f - lb1) * s1;
        g[i][0] = __builtin_amdgcn_logf(f0) * LN2; g[i][1] = __builtin_amdgcn_logf(f1) * LN2;
        kk[i][0] = (1.0f - lb0) * (1.0f - s0); kk[i][1] = (1.0f - lb1) * (1.0f - s1); }
}
__device__ __forceinline__ void seg_scan(float (&g)[8][2], int dir, float& t0, float& t1) {
    if (dir == 0) {
#pragma unroll
        for (int i = 1; i < 8; ++i) { g[i][0] += g[i - 1][0]; g[i][1] += g[i - 1][1]; }
        t0 = g[7][0]; t1 = g[7][1];
    } else {
#pragma unroll
        for (int i = 6; i >= 0; --i) { g[i][0] += g[i + 1][0]; g[i][1] += g[i + 1][1]; }
        t0 = g[0][0]; t1 = g[0][1];
    }
}
constexpr int R_VT = 0, R_KT = 18432, R_TS = 55296, R_QT = 63488, R_KT2 = 80896, R_QH = 98304, R_PB = 115712, R_OS = 63488;

__device__ __forceinline__ void lb_pair(const float* lbl, int dir, int ch, float& lb0, float& lb1) {
    const float a0 = lbl[dir * 1024 + ch], a1 = lbl[dir * 1024 + 512 + ch], b0 = lbl[dir * 1024 + ch + 1], b1 = lbl[dir * 1024 + 512 + ch + 1];
    lb0 = 1.0f / (1.0f + expf(a1 - a0)); lb1 = 1.0f / (1.0f + expf(b1 - b0));
}

__device__ __forceinline__ void rec_local(LAS unsigned char* lds, const bf16_t* PR, const float* lbl, bf16_t* LST, float* DC, int item, int tid) {
    const int b = item >> 9, h = (item >> 7) & 3, c = item & 127;
    const int lane = tid & 63, seg = tid >> 6, d0 = 2 * lane, r32 = lane & 31, hi = lane >> 5;
    const size_t row0 = (size_t)b * T + 64 * c + 8 * seg;
    {
        unsigned vv[8];
#pragma unroll
        for (int i = 0; i < 8; ++i) vv[i] = *(const unsigned*)(PR + (row0 + i) * 2560 + 1536 + h * 128 + d0);
        u32x4 lo, hi4;
        lo.x = (vv[0] & 0xffffu) | (vv[1] << 16); lo.y = (vv[2] & 0xffffu) | (vv[3] << 16); lo.z = (vv[4] & 0xffffu) | (vv[5] << 16); lo.w = (vv[6] & 0xffffu) | (vv[7] << 16);
        hi4.x = (vv[0] >> 16) | (vv[1] & 0xffff0000u); hi4.y = (vv[2] >> 16) | (vv[3] & 0xffff0000u); hi4.z = (vv[4] >> 16) | (vv[5] & 0xffff0000u); hi4.w = (vv[6] >> 16) | (vv[7] & 0xffff0000u);
        *(LAS u32x4*)(lds + R_VT + (d0 * 72 + 8 * seg) * 2) = lo; *(LAS u32x4*)(lds + R_VT + ((d0 + 1) * 72 + 8 * seg) * 2) = hi4;
    }
    float g[2][8][2], kk[2][8][2];
#pragma unroll
    for (int dir = 0; dir < 2; ++dir) {
        float lb0, lb1; lb_pair(lbl, dir, h * 128 + d0, lb0, lb1);
        rec_gates(PR + row0 * 2560 + 512 + dir * 512 + h * 128 + d0, lb0, lb1, g[dir], kk[dir]);
        float t0, t1; seg_scan(g[dir], dir, t0, t1);
        *(LAS f32x2*)(lds + R_TS + ((dir * 8 + seg) * 128 + d0) * 4) = (f32x2){t0, t1};
    }
    LDSW(); __syncthreads();
#pragma unroll
    for (int dir = 0; dir < 2; ++dir) {
        float off0 = 0.f, off1 = 0.f, tot0 = 0.f, tot1 = 0.f;
#pragma unroll
        for (int s = 0; s < 8; ++s) { const f32x2 t = *(const LAS f32x2*)(lds + R_TS + ((dir * 8 + s) * 128 + d0) * 4); tot0 += t.x; tot1 += t.y;
            const bool before = dir == 0 ? (s < seg) : (s > seg); if (before) { off0 += t.x; off1 += t.y; } }
        float k0[8], k1[8];
#pragma unroll
        for (int i = 0; i < 8; ++i) { k0[i] = kk[dir][i][0] * fexp(tot0 - (g[dir][i][0] + off0)); k1[i] = kk[dir][i][1] * fexp(tot1 - (g[dir][i][1] + off1)); }
#if defined(RL_TEST) && RL_TEST == 1
#pragma unroll
        for (int i = 0; i < 8; ++i) { k0[i] = 1.0f; k1[i] = 1.0f; }
#endif
        u32x4 w0, w1; w0.x = pk(k0[0], k0[1]); w0.y = pk(k0[2], k0[3]); w0.z = pk(k0[4], k0[5]); w0.w = pk(k0[6], k0[7]);
        w1.x = pk(k1[0], k1[1]); w1.y = pk(k1[2], k1[3]); w1.z = pk(k1[4], k1[5]); w1.w = pk(k1[6], k1[7]);
        *(LAS u32x4*)(lds + R_KT + dir * 18432 + (d0 * 72 + 8 * seg) * 2) = w0; *(LAS u32x4*)(lds + R_KT + dir * 18432 + ((d0 + 1) * 72 + 8 * seg) * 2) = w1;
        if (seg == 0) { const int chain = (b * 4 + h) * 2 + dir; *(f32x2*)(DC + ((size_t)(chain * 128 + c)) * 128 + d0) = (f32x2){fexp(tot0), fexp(tot1)}; }
    }
    LDSW(); __syncthreads();
    {
        const int dir = seg >> 2, mt = seg & 3;
        f32x16 acc[4];
#pragma unroll
        for (int n = 0; n < 4; ++n) acc[n] = (f32x16){};
#pragma unroll
        for (int ks = 0; ks < 4; ++ks) { const bf16x8 a = *(const LAS bf16x8*)(lds + R_VT + ((32 * mt + r32) * 72 + 16 * ks + 8 * hi) * 2);
#pragma unroll
            for (int n = 0; n < 4; ++n) { const bf16x8 bb = *(const LAS bf16x8*)(lds + R_KT + dir * 18432 + ((32 * n + r32) * 72 + 16 * ks + 8 * hi) * 2);
                acc[n] = __builtin_amdgcn_mfma_f32_32x32x16_bf16(a, bb, acc[n], 0, 0, 0); } }
        const int chain = (b * 4 + h) * 2 + dir; bf16_t* L = LST + ((size_t)(chain * 128 + c) << 14);
#pragma unroll
        for (int n = 0; n < 4; ++n)
#pragma unroll
            for (int r = 0; r < 16; ++r) { const int dv = 32 * mt + crow(r, hi), dk = 32 * n + r32; L[dv * 128 + dk] = (bf16_t)(pk(acc[n][r], 0.f) & 0xffffu); }
    }
    __syncthreads();
}

__device__ __forceinline__ void rec_out(LAS unsigned char* lds, const bf16_t* PR, const float* lbl, const bf16_t* SP, const float* AO, const float* ASS,
                                        const float* attn_gain, const float* rec_gain, bf16_t* MIX, int item, int h, float& ra, int tid) {
    const int b = item >> 7, c = item & 127;
    const int lane = tid & 63, seg = tid >> 6, d0 = 2 * lane, r32 = lane & 31, hi = lane >> 5;
    const size_t rowc = (size_t)b * T + 64 * c, row0 = rowc + 8 * seg;
    {
        unsigned vv[8];
#pragma unroll
        for (int i = 0; i < 8; ++i) vv[i] = *(const unsigned*)(PR + (row0 + i) * 2560 + 1536 + h * 128 + d0);
        u32x4 lo, hi4;
        lo.x = (vv[0] & 0xffffu) | (vv[1] << 16); lo.y = (vv[2] & 0xffffu) | (vv[3] << 16); lo.z = (vv[4] & 0xffffu) | (vv[5] << 16); lo.w = (vv[6] & 0xffffu) | (vv[7] << 16);
        hi4.x = (vv[0] >> 16) | (vv[1] & 0xffff0000u); hi4.y = (vv[2] >> 16) | (vv[3] & 0xffff0000u); hi4.z = (vv[4] >> 16) | (vv[5] & 0xffff0000u); hi4.w = (vv[6] >> 16) | (vv[7] & 0xffff0000u);
        *(LAS u32x4*)(lds + R_VT + (d0 * 72 + 8 * seg) * 2) = lo; *(LAS u32x4*)(lds + R_VT + ((d0 + 1) * 72 + 8 * seg) * 2) = hi4;
    }
    float q[8][2];
#pragma unroll
    for (int i = 0; i < 8; ++i) { const unsigned u = *(const unsigned*)(PR + (row0 + i) * 2560 + h * 128 + d0); q[i][0] = bf_lo(u); q[i][1] = bf_hi(u); }
    const int mt = seg >> 2, nt = seg & 3;
    const int bt = (seg >> 1) & 1, bs = seg & 1;
    f32x16 oacc = (f32x16){}, pacc = (f32x16){};
#pragma unroll 1
    for (int dir = 0; dir < 2; ++dir) {
        float g[8][2], kk[8][2];
        float lb0, lb1; lb_pair(lbl, dir, h * 128 + d0, lb0, lb1);
        rec_gates(PR + row0 * 2560 + 512 + dir * 512 + h * 128 + d0, lb0, lb1, g, kk);
        float t0, t1; seg_scan(g, dir, t0, t1);
        *(LAS f32x2*)(lds + R_TS + (seg * 128 + d0) * 4) = (f32x2){t0, t1};
        LDSW(); __syncthreads();
        float off0 = 0.f, off1 = 0.f, ref0 = 0.f, ref1 = 0.f;
#pragma unroll
        for (int s = 0; s < 8; ++s) { const f32x2 t = *(const LAS f32x2*)(lds + R_TS + (s * 128 + d0) * 4);
            const bool before = dir == 0 ? (s < seg) : (s > seg); if (before) { off0 += t.x; off1 += t.y; }
            const bool inref = dir == 0 ? (s < 4) : (s >= 4); if (inref) { ref0 += t.x; ref1 += t.y; } }
#pragma unroll
        for (int i = 0; i < 8; ++i) {
            const float b0 = g[i][0] + off0, b1 = g[i][1] + off1;
            const float eq0 = fexp(b0 - ref0), eq1 = fexp(b1 - ref1), ek0 = fexp(ref0 - b0), ek1 = fexp(ref1 - b1), eh0 = fexp(b0), eh1 = fexp(b1);
            const int ro = ((8 * seg + i) * 136 + d0) * 2;
            *(LAS unsigned*)(lds + R_QT + ro) = pk(q[i][0] * eq0, q[i][1] * eq1);
            *(LAS unsigned*)(lds + R_KT2 + ro) = pk(kk[i][0] * ek0, kk[i][1] * ek1);
            *(LAS unsigned*)(lds + R_QH + ro) = pk(q[i][0] * eh0, q[i][1] * eh1);
        }
        LDSW(); __syncthreads();
        if (seg < 4 && !((dir == 0 && bt == 0 && bs == 1) || (dir == 1 && bt == 1 && bs == 0))) {
            f32x16 sc = (f32x16){};
#pragma unroll
            for (int ks = 0; ks < 8; ++ks) {
                const bf16x8 a = *(const LAS bf16x8*)(lds + R_QT + ((32 * bt + r32) * 136 + 16 * ks + 8 * hi) * 2);
                const bf16x8 bb = *(const LAS bf16x8*)(lds + R_KT2 + ((32 * bs + r32) * 136 + 16 * ks + 8 * hi) * 2);
                sc = __builtin_amdgcn_mfma_f32_32x32x16_bf16(a, bb, sc, 0, 0, 0); }
#pragma unroll
            for (int r = 0; r < 16; ++r) { const int t = 32 * bt + crow(r, hi), s = 32 * bs + r32; const bool keep = dir == 0 ? (s <= t) : (s >= t); pacc[r] += keep ? sc[r] : 0.f; }
        }
        {
            const int chain = (b * 4 + h) * 2 + dir; const bf16_t* S = SP + ((size_t)(chain * 128 + c) << 14) + (size_t)(32 * nt + r32) * 128 + 8 * hi;
            bf16x8 sb[8];
#pragma unroll
            for (int ks = 0; ks < 8; ++ks) sb[ks] = *(const bf16x8*)(S + 16 * ks);
#pragma unroll
            for (int ks = 0; ks < 8; ++ks) { const bf16x8 a = *(const LAS bf16x8*)(lds + R_QH + ((32 * mt + r32) * 136 + 16 * ks + 8 * hi) * 2);
                oacc = __builtin_amdgcn_mfma_f32_32x32x16_bf16(a, sb[ks], oacc, 0, 0, 0); }
        }
        LDSW(); __syncthreads();
    }
    if (seg < 4) {
#pragma unroll
        for (int r = 0; r < 16; ++r) { const int t = 32 * bt + crow(r, hi), s = 32 * bs + r32; *(LAS bf16_t*)(lds + R_PB + (t * 72 + s) * 2) = (bf16_t)(pk(pacc[r], 0.f) & 0xffffu); }
    }
    LDSW(); __syncthreads();
#pragma unroll
    for (int ks = 0; ks < 4; ++ks) { const bf16x8 a = *(const LAS bf16x8*)(lds + R_PB + ((32 * mt + r32) * 72 + 16 * ks + 8 * hi) * 2);
        const bf16x8 bb = *(const LAS bf16x8*)(lds + R_VT + ((32 * nt + r32) * 72 + 16 * ks + 8 * hi) * 2);
        oacc = __builtin_amdgcn_mfma_f32_32x32x16_bf16(a, bb, oacc, 0, 0, 0); }
#pragma unroll
    for (int r = 0; r < 16; ++r) *(LAS float*)(lds + R_OS + ((32 * mt + crow(r, hi)) * 132 + 32 * nt + r32) * 4) = oacc[r];
    LDSW(); __syncthreads();
    {
        const int row = tid >> 3, sg = tid & 7; const size_t grow = rowc + row;
        f32x4 o4[4]; float ss = 0.f;
#pragma unroll
        for (int j = 0; j < 4; ++j) { o4[j] = *(const LAS f32x4*)(lds + R_OS + (row * 132 + 16 * sg + 4 * j) * 4); ss += (o4[j][0] * o4[j][0] + o4[j][1] * o4[j][1]) + (o4[j][2] * o4[j][2] + o4[j][3] * o4[j][3]); }
        ss += __shfl_xor(ss, 1); ss += __shfl_xor(ss, 2); ss += __shfl_xor(ss, 4);
        const float rstd = 1.0f / sqrtf(ss * (1.0f / 128.0f) + EPS);
        const u32x4 gz0 = *(const u32x4*)(PR + grow * 2560 + 2048 + h * 128 + 16 * sg), gz1 = *(const u32x4*)(PR + grow * 2560 + 2048 + h * 128 + 16 * sg + 8);
        const unsigned gz[8] = {gz0.x, gz0.y, gz0.z, gz0.w, gz1.x, gz1.y, gz1.z, gz1.w};
        float res[16];
#pragma unroll
        for (int e = 0; e < 16; ++e) { const float gt = (e & 1) ? bf_hi(gz[e >> 1]) : bf_lo(gz[e >> 1]); res[e] = o4[e >> 2][e & 3] * rstd * rec_gain[16 * sg + e] * pg8::silu_f(gt); }
        u32x4 w0, w1; w0.x = pk(res[0], res[1]); w0.y = pk(res[2], res[3]); w0.z = pk(res[4], res[5]); w0.w = pk(res[6], res[7]);
        w1.x = pk(res[8], res[9]); w1.y = pk(res[10], res[11]); w1.z = pk(res[12], res[13]); w1.w = pk(res[14], res[15]);
        *(u32x4*)(MIX + grow * 1024 + 512 + h * 128 + 16 * sg) = w0; *(u32x4*)(MIX + grow * 1024 + 512 + h * 128 + 16 * sg + 8) = w1;
        if (h == 0) { float sa = 0.f;
#pragma unroll
            for (int j = 0; j < 16; ++j) { const f32x4 a4 = *(const f32x4*)(AO + grow * 512 + 64 * sg + 4 * j); sa += (a4[0] * a4[0] + a4[1] * a4[1]) + (a4[2] * a4[2] + a4[3] * a4[3]); }
            sa += __shfl_xor(sa, 1); sa += __shfl_xor(sa, 2); sa += __shfl_xor(sa, 4);
            ra = 1.0f / sqrtf(sa * (1.0f / 512.0f) + EPS); }
        float av[16];
#pragma unroll
        for (int j = 0; j < 4; ++j) { const f32x4 a4 = *(const f32x4*)(AO + grow * 512 + h * 128 + 16 * sg + 4 * j); const f32x4 g4 = *(const f32x4*)(attn_gain + h * 128 + 16 * sg + 4 * j);
            av[4 * j + 0] = a4[0] * ra * g4[0]; av[4 * j + 1] = a4[1] * ra * g4[1]; av[4 * j + 2] = a4[2] * ra * g4[2]; av[4 * j + 3] = a4[3] * ra * g4[3]; }
        w0.x = pk(av[0], av[1]); w0.y = pk(av[2], av[3]); w0.z = pk(av[4], av[5]); w0.w = pk(av[6], av[7]);
        w1.x = pk(av[8], av[9]); w1.y = pk(av[10], av[11]); w1.z = pk(av[12], av[13]); w1.w = pk(av[14], av[15]);
        *(u32x4*)(MIX + grow * 1024 + h * 128 + 16 * sg) = w0; *(u32x4*)(MIX + grow * 1024 + h * 128 + 16 * sg + 8) = w1;
    }
    __syncthreads();
}

__device__ __forceinline__ void qk_norm_rope(bf16_t* PA, const float* qg, const float* kg, int gw, int ngw, int lane) {
    const int a = lane & 15, half = a >> 3, j0 = (a & 3) * 8; const bool isx2 = (a & 4) != 0;
    float invf[8];
#pragma unroll
    for (int e = 0; e < 8; ++e) invf[e] = __builtin_amdgcn_exp2f(-(float)(j0 + e) * 0.41524101186092029f) * 0.15915494309189535f;
    for (int gi = gw; gi < M * 6 / 4; gi += 2 * ngw) {
        bf16_t* pp[2]; u32x4 rawv[2]; int rows[2], hvs[2];
#pragma unroll
        for (int q2 = 0; q2 < 2; ++q2) { const int g2 = gi + q2 * ngw; const int vid = g2 * 4 + (lane >> 4); rows[q2] = vid / 6; hvs[q2] = vid - rows[q2] * 6;
            pp[q2] = PA + (size_t)rows[q2] * 1024 + hvs[q2] * 128 + 8 * a; rawv[q2] = (g2 < M * 6 / 4) ? *(const u32x4*)pp[q2] : (u32x4){0u, 0u, 0u, 0u}; }
#pragma unroll
        for (int q2 = 0; q2 < 2; ++q2) {
            const int row = rows[q2], hv = hvs[q2]; const u32x4 raw = rawv[q2]; const unsigned rw[4] = {raw.x, raw.y, raw.z, raw.w};
            float x[8]; float ss = 0.f;
#pragma unroll
            for (int e = 0; e < 4; ++e) { x[2 * e] = bf_lo(rw[e]); x[2 * e + 1] = bf_hi(rw[e]); ss += x[2 * e] * x[2 * e] + x[2 * e + 1] * x[2 * e + 1]; }
            ss += __shfl_xor(ss, 1); ss += __shfl_xor(ss, 2); ss += __shfl_xor(ss, 4); ss += __shfl_xor(ss, 8);
            const float rstd = 1.0f / sqrtf(ss * (1.0f / 128.0f) + EPS);
            const float* gn = (hv < 4 ? qg : kg) + 8 * a;
            float y[8], yp[8];
#pragma unroll
            for (int e = 0; e < 8; ++e) y[e] = x[e] * rstd * gn[e];
#pragma unroll
            for (int e = 0; e < 8; ++e) yp[e] = __shfl_xor(y[e], 4);
            const int t = row & (T - 1); const float id = (float)(half ? (t & 63) : (t >> 6));
            float o[8];
#pragma unroll
            for (int e = 0; e < 8; ++e) { const float rev = id * invf[e], fr = rev - floorf(rev); const float cs = __builtin_amdgcn_cosf(fr), sn = __builtin_amdgcn_sinf(fr);
                o[e] = isx2 ? (y[e] * cs + yp[e] * sn) : (y[e] * cs - yp[e] * sn); }
            u32x4 w; w.x = pk(o[0], o[1]); w.y = pk(o[2], o[3]); w.z = pk(o[4], o[5]); w.w = pk(o[6], o[7]);
            if (gi + q2 * ngw < M * 6 / 4) *(u32x4*)pp[q2] = w;
        }
    }
}

__global__ void __launch_bounds__(NTH, 2) hybrid_fwd(Args args) {
    extern __shared__ __attribute__((aligned(16))) unsigned char lds_raw[];
    LAS unsigned char* lds = (LAS unsigned char*)lds_raw;
    const int tid = threadIdx.x, lane = tid & 63, wave = __builtin_amdgcn_readfirstlane(tid >> 6);
    const int G = gridDim.x, gw = blockIdx.x * NWAVES + wave, NGW = G * NWAVES;
    unsigned char* ws = args.ws;
    const float* x = args.in[0];
    float* out = args.out;
    float* SSA = (float*)(ws + WS_SSA); float* SSB = (float*)(ws + WS_SSB); float* DC = (float*)(ws + WS_DC); float* ASS = (float*)(ws + WS_ASS);
    bf16_t* W1A = (bf16_t*)(ws + WS_W1A); bf16_t* W2A = (bf16_t*)(ws + WS_W2A); bf16_t* WIN = (bf16_t*)(ws + WS_WIN); bf16_t* WO = (bf16_t*)(ws + WS_WO);
    bf16_t* W1B = (bf16_t*)(ws + WS_W1B); bf16_t* W2B = (bf16_t*)(ws + WS_W2B);
    bf16_t* XB = (bf16_t*)(ws + WS_X); float* AO = (float*)(ws + WS_X); bf16_t* X2B = (bf16_t*)(ws + WS_X);
    bf16_t* H = (bf16_t*)(ws + WS_B); bf16_t* PA = (bf16_t*)(ws + WS_B); bf16_t* PR = (bf16_t*)(ws + WS_PR); bf16_t* MIX = (bf16_t*)(ws + WS_B);
    bf16_t* LST = (bf16_t*)(ws + WS_C);
    const int lo = args.lo, hi = args.hi;
#ifdef PH_ONLY
#define IN(k) ((k) == PH_ONLY && lo <= (k) && (k) < hi)
#else
#define IN(k) (lo <= (k) && (k) < hi)
#endif
#ifdef TS_LO
    unsigned long long ts_t0 = 0, ts_t1 = 0;
#define TS_A(k) do { if ((k) == TS_LO) ts_t0 = __builtin_amdgcn_s_memrealtime(); } while (0)
#define TS_B(k) do { if ((k) == TS_HI) ts_t1 = __builtin_amdgcn_s_memrealtime(); } while (0)
#else
#define TS_A(k) do {} while (0)
#define TS_B(k) do {} while (0)
#endif
#define SEAM(k) do { if (IN(k) && IN((k) + 1)) { cg::this_grid().sync(); } TS_B(k); TS_A((k) + 1); } while (0)

    TS_A(0);
    if (IN(0)) {
        LAS float* scr = (LAS float*)(lds + wave * 8448);
        constexpr int I1 = (DM / 64) * (2 * FF / 32), I2 = (FF / 64) * (DM / 32), I3 = (DM / 64) * (NIN / 32), I4 = (DM / 64) * (DM / 32);
        constexpr int NITEMS = 2 * I1 + 2 * I2 + I3 + I4;
        for (int it = gw; it < NITEMS; it += NGW) {
            int r = it;
            if (r < I1) { tr_item(args.in[2], DM, 2 * FF, W1A, args.in[1], true, scr, r, lane); continue; } r -= I1;
            if (r < I2) { tr_item(args.in[3], FF, DM, W2A, nullptr, false, scr, r, lane); continue; } r -= I2;
            if (r < I3) { tr_item(args.in[5], DM, NIN, WIN, args.in[4], false, scr, r, lane); continue; } r -= I3;
            if (r < I4) { tr_item(args.in[11], DM, DM, WO, nullptr, false, scr, r, lane); continue; } r -= I4;
            if (r < I1) { tr_item(args.in[13], DM, 2 * FF, W1B, args.in[12], true, scr, r, lane); continue; } r -= I1;
            tr_item(args.in[14], FF, DM, W2B, nullptr, false, scr, r, lane);
        }
        for (int m0 = gw; m0 < M; m0 += 2 * NGW) {
            f32x4 v[2][4]; float sq[2];
#pragma unroll
            for (int q2 = 0; q2 < 2; ++q2) { const int m = m0 + q2 * NGW < M ? m0 + q2 * NGW : m0; const f32x4* xr = (const f32x4*)(x + (size_t)m * DM) + lane;
#pragma unroll
                for (int j = 0; j < 4; ++j) v[q2][j] = xr[64 * j]; }
#pragma unroll
            for (int q2 = 0; q2 < 2; ++q2) { float s = 0.f;
#pragma unroll
                for (int j = 0; j < 4; ++j) s += (v[q2][j][0] * v[q2][j][0] + v[q2][j][1] * v[q2][j][1]) + (v[q2][j][2] * v[q2][j][2] + v[q2][j][3] * v[q2][j][3]);
                sq[q2] = wave_sum(s); }
#pragma unroll
            for (int q2 = 0; q2 < 2; ++q2) { const int m = m0 + q2 * NGW; if (m < M) { u32x2* o8 = (u32x2*)(XB + (size_t)m * DM) + lane;
#pragma unroll
                for (int j = 0; j < 4; ++j) o8[64 * j] = (u32x2){pk(v[q2][j][0], v[q2][j][1]), pk(v[q2][j][2], v[q2][j][3])};
                if (lane < 16) SSA[(size_t)m * 16 + lane] = lane == 0 ? sq[q2] : 0.f; } }
        }
        __syncthreads();
    }
    SEAM(0);
    if (IN(1)) { pg8::Gemm g{XB, W1A, M, 2 * FF, DM}; pg8::StaticOrder S; S.init(M, 2 * FF, G, (int)blockIdx.x); pg8::EpiSwiGLU E{H, FF, SSA};
        pg8::gemm_phase<pg8::EpiSwiGLU, pg8::StaticOrder, true, true>(lds, g, S, E); }
    SEAM(1);
    if (IN(2)) { pg8::Gemm g{H, W2A, M, DM, FF}; pg8::StaticOrder S; S.init(M, DM, G, (int)blockIdx.x); pg8::EpiResid E{x, out, XB, SSB, 0.5f};
        pg8::gemm_phase<pg8::EpiResid, pg8::StaticOrder, true, true>(lds, g, S, E); }
    SEAM(2);
    if (IN(3)) { pg8::Gemm g{XB, WIN, M, NIN, DM}; pg8::StaticOrder S; S.init(M, NIN, G, (int)blockIdx.x); pg8::EpiProj E{PA, PR, SSB};
        pg8::gemm_phase<pg8::EpiProj, pg8::StaticOrder, true, true>(lds, g, S, E); }
    SEAM(3);
    if (IN(4)) {
        qk_norm_rope(PA, args.in[6], args.in[7], gw, NGW, lane);
        for (int it = blockIdx.x; it < 1024; it += G) rec_local(lds, PR, args.in[9], LST, DC, it, tid);
    }
    SEAM(4);
    if (IN(5)) {
#ifndef X_NOSCAN
        for (int p = blockIdx.x * NTH + tid; p < 16 * 8192; p += G * NTH) {
            const int chain = p >> 13, pair = p & 8191, dk0 = (pair & 63) * 2, dir = chain & 1;
            float s0 = 0.f, s1 = 0.f;
#pragma unroll 16
            for (int st = 0; st < 128; ++st) { const int c = dir ? 127 - st : st;
                unsigned* ptr = (unsigned*)(LST + ((size_t)(chain * 128 + c) << 14)) + pair;
                const unsigned l = *ptr; const f32x2 dc = *(const f32x2*)(DC + (size_t)(chain * 128 + c) * 128 + dk0);
                *ptr = pk(s0, s1);
                s0 = dc.x * s0 + bf_lo(l); s1 = dc.y * s1 + bf_hi(l); }
        }
#endif
#ifdef X_NOLOOP
        { const int u = blockIdx.x;
#else
        for (int u = blockIdx.x; u < 256; u += G) {
#endif
            const int xcd = u & 7, j = u >> 3, pair = xcd >> 1, b = pair >> 1, kvh = pair & 1, h = 2 * kvh + (xcd & 1);
            const size_t r0 = (size_t)b * T + 256 * j;
            att::attn_dense_body<att::bf16>((const att::bf16*)(PA + r0 * 1024 + h * 128), (const att::bf16*)(PA + (size_t)b * T * 1024 + 512 + kvh * 128),
                                            (const att::bf16*)(PA + (size_t)b * T * 1024 + 768 + kvh * 128), AO + r0 * 512 + h * 128, T, (char*)lds_raw);
            __syncthreads();
        }
    }
    SEAM(5);
    if (IN(6)) { for (int it = blockIdx.x; it < 256; it += G) { float ra = 0.f;
#pragma unroll 1
        for (int h = 0; h < 4; ++h) rec_out(lds, PR, args.in[9], LST, AO, ASS, args.in[8], args.in[10], MIX, it, h, ra, tid); } }
    SEAM(6);
    if (IN(7)) { pg8::Gemm g{MIX, WO, M, DM, DM}; pg8::StaticOrder S; S.init(M, DM, G, (int)blockIdx.x); pg8::EpiResid E{out, out, X2B, SSA, 1.0f};
        pg8::gemm_phase<pg8::EpiResid, pg8::StaticOrder, true, true>(lds, g, S, E); }
    SEAM(7);
    if (IN(8)) { pg8::Gemm g{X2B, W1B, M, 2 * FF, DM}; pg8::StaticOrder S; S.init(M, 2 * FF, G, (int)blockIdx.x); pg8::EpiSwiGLU E{H, FF, SSA};
        pg8::gemm_phase<pg8::EpiSwiGLU, pg8::StaticOrder, true, true>(lds, g, S, E); }
    SEAM(8);
    if (IN(9)) { pg8::Gemm g{H, W2B, M, DM, FF}; pg8::StaticOrder S; S.init(M, DM, G, (int)blockIdx.x); pg8::EpiResid E{out, out, nullptr, nullptr, 0.5f};
        pg8::gemm_phase<pg8::EpiResid, pg8::StaticOrder, true, true>(lds, g, S, E); }
    SEAM(9);
    if (IN(10)) {
        const float* fg = args.in[15];
        for (int m = gw; m < M; m += NGW) {
            f32x4* xr = (f32x4*)(out + (size_t)m * DM) + lane; f32x4 v[4]; float s = 0.f;
#pragma unroll
            for (int j = 0; j < 4; ++j) { v[j] = xr[64 * j]; s += (v[j][0] * v[j][0] + v[j][1] * v[j][1]) + (v[j][2] * v[j][2] + v[j][3] * v[j][3]); }
            const float rstd = 1.0f / sqrtf(wave_sum(s) * (1.0f / DM) + EPS);
#pragma unroll
            for (int j = 0; j < 4; ++j) { const f32x4 gn = *((const f32x4*)fg + lane + 64 * j); xr[64 * j] = v[j] * rstd * gn; }
        }
    }
#ifdef TS_LO
    TS_B(10);
    cg::this_grid().sync();
    if (blockIdx.x == 0) { const unsigned K = (unsigned)(ts_t1 - ts_t0); for (unsigned i = tid; i < K && i < 300000u; i += NTH) out[i] += 0.1f; }
#endif
#undef IN
#undef SEAM
}
}

#ifdef DBG
__global__ void dbg_dump_bf16(const unsigned short* src, float* out, size_t n) { for (size_t i = blockIdx.x * (size_t)blockDim.x + threadIdx.x; i < n; i += (size_t)gridDim.x * blockDim.x) out[i] = __uint_as_float((unsigned)src[i] << 16); }
__global__ void dbg_dump_f32(const float* src, float* out, size_t n) { for (size_t i = blockIdx.x * (size_t)blockDim.x + threadIdx.x; i < n; i += (size_t)gridDim.x * blockDim.x) out[i] = src[i]; }
#endif
extern "C" void kernel_launch(void* const* d_in, const int* in_sizes, int n_in, void* d_out, int out_size, void* d_ws, size_t ws_size, hipStream_t stream) {
    using namespace mk;
    static int grid = 0;
    if (grid == 0) {
        if (n_in != 16 || in_sizes[0] != M * DM || out_size != M * DM || ws_size < WS_END) {
            fprintf(stderr, "kernel_launch: built for 16 inputs, x/out of %d floats, >= %zu bytes of workspace; got n_in %d in0 %d out %d ws %zu\n", M * DM, (size_t)WS_END, n_in, n_in > 0 ? in_sizes[0] : -1, out_size, ws_size);
            grid = -1; return; }
        int dev = 0, cus = 0, per_cu = 0;
        hipGetDevice(&dev); hipDeviceGetAttribute(&cus, hipDeviceAttributeMultiprocessorCount, dev);
        if (hipFuncSetAttribute((const void*)hybrid_fwd, hipFuncAttributeMaxDynamicSharedMemorySize, LDS_BYTES) != hipSuccess) { fprintf(stderr, "kernel_launch: hipFuncSetAttribute failed\n"); grid = -1; return; }
        if (hipOccupancyMaxActiveBlocksPerMultiprocessor(&per_cu, (const void*)hybrid_fwd, NTH, LDS_BYTES) != hipSuccess || per_cu < 1) { fprintf(stderr, "kernel_launch: occupancy query says %d\n", per_cu); per_cu = 1; }
        (void)hipGetLastError();
        grid = cus * per_cu; if (grid > 256) grid = 256;
    }
    if (grid < 0) return;
    Args a{};
    for (int i = 0; i < 16; ++i) a.in[i] = (const float*)d_in[i];
    a.out = (float*)d_out; a.ws = (unsigned char*)d_ws;
#if MK_LAUNCHES == 1
    a.lo = 0; a.hi = 11;
    void* kargs[] = {&a};
    hipError_t e = hipLaunchCooperativeKernel((const void*)hybrid_fwd, dim3(grid), dim3(NTH), kargs, LDS_BYTES, stream);
    if (e != hipSuccess) fprintf(stderr, "kernel_launch: cooperative launch failed: %s (grid %d)\n", hipGetErrorString(e), grid);
#else
#ifdef DBG
    const int last = DBG == 7 ? 3 : DBG == 6 ? 6 : DBG == 5 ? 5 : DBG == 4 ? 4 : DBG == 3 ? 3 : DBG == 1 ? 1 : 2;
    for (int ph = 0; ph <= last; ++ph) { a.lo = ph; a.hi = ph + 1; hipLaunchKernelGGL(hybrid_fwd, dim3(grid), dim3(NTH), LDS_BYTES, stream, a); }
    const size_t n = (size_t)M * DM; unsigned char* w = (unsigned char*)d_ws;
    if (DBG == 6) hipLaunchKernelGGL(dbg_dump_bf16, dim3(1024), dim3(256), 0, stream, (const unsigned short*)(w + WS_B), (float*)d_out, n);
    if (DBG == 5) hipLaunchKernelGGL(dbg_dump_f32, dim3(1024), dim3(256), 0, stream, (const float*)(w + WS_X), (float*)d_out, n / 2);
    if (DBG == 4) hipLaunchKernelGGL(dbg_dump_bf16, dim3(1024), dim3(256), 0, stream, (const unsigned short*)(w + WS_C), (float*)d_out, n);
    if (DBG == 3) hipLaunchKernelGGL(dbg_dump_bf16, dim3(1024), dim3(256), 0, stream, (const unsigned short*)(w + WS_B), (float*)d_out, n);
    if (DBG == 7) hipLaunchKernelGGL(dbg_dump_bf16, dim3(1024), dim3(256), 0, stream, (const unsigned short*)(w + WS_PR), (float*)d_out, n);
    if (DBG == 1) hipLaunchKernelGGL(dbg_dump_bf16, dim3(1024), dim3(256), 0, stream, (const unsigned short*)(w + WS_B), (float*)d_out, n);
#else
    for (int ph = 0; ph < 11; ++ph) { a.lo = ph; a.hi = ph + 1; hipLaunchKernelGGL(hybrid_fwd, dim3(grid), dim3(NTH), LDS_BYTES, stream, a); }
#endif
#endif
}
```

```cpp
#include <hip/hip_runtime.h>
#include <hip/hip_bf16.h>
#include <hip/hip_cooperative_groups.h>
#include <cstdio>
#include <cstdint>
namespace cg = cooperative_groups;
#ifndef MK_LAUNCHES
#define MK_LAUNCHES 1
#endif
namespace pg8 {
#define PG8_LAS __attribute__((address_space(3)))
typedef unsigned short bf16_t;
typedef short bf16x8 __attribute__((ext_vector_type(8)));
typedef float f32x4 __attribute__((ext_vector_type(4)));
typedef unsigned u32x4 __attribute__((ext_vector_type(4)));
constexpr int BM = 256, BK = 64, HALF = 128, HTB = HALF * BK * 2  , STAGE_BYTES = 8 * HTB, NXCD = 8, WGM = 8;

__host__ __device__ __forceinline__ int lds_byte(int r, int c) { const int st = (r >> 4) * 2 + (c >> 5), rr = r & 15, cc = c & 31, ob = rr * 64 + cc * 2; return st * 1024 + (ob ^ (((ob >> 9) & 1) << 5)); }
__host__ __device__ __forceinline__ void stage_rc(int b, int& R, int& C) { const int st = b / 1024, sb = b % 1024, swz = sb ^ (((sb >> 9) & 1) << 5); R = (st >> 1) * 16 + swz / 64; C = (st & 1) * 32 + (swz % 64) / 2; }
__host__ __device__ __forceinline__ int perm32(int rho) { const int n = rho >> 4, i = rho & 15; return 8 * (i >> 2) + 4 * n + (i & 3); }

struct Unit { int pm, pn; };
struct Gemm { const bf16_t* A; const bf16_t* Bt; int M, N, K; };

struct StaticOrder {
    int nM, nN, nwg, G, c;
    __host__ __device__ void init(int M, int N, int G_, int c_) { nM = M / BM; nN = N / BM; nwg = nM * nN; G = G_; c = c_; }
    __host__ __device__ bool next(int i, Unit& u) const {
        const long L = (long)i * G + c; if (L >= nwg) return false;
        int wgid = (int)L; { const int q = nwg / NXCD, r = nwg % NXCD, xcd = wgid % NXCD, off = wgid / NXCD; wgid = (xcd < r ? xcd * (q + 1) : r * (q + 1) + (xcd - r) * q) + off; }
        const int nig = WGM * nN, gid = wgid / nig, fm = gid * WGM, gsz = (nM - fm) < WGM ? (nM - fm) : WGM;
        u.pm = fm + ((wgid % nig) % gsz); u.pn = (wgid % nig) / gsz; return true;
    }
    __device__ __forceinline__ void a_ready(const Unit&) const {}
    __device__ __forceinline__ void done(const Unit&) const {}
};

typedef __bf16 bf16x2_cv __attribute__((ext_vector_type(2)));
typedef float f32x2_cv __attribute__((ext_vector_type(2)));
__device__ __forceinline__ unsigned cvt_pk_bf16(float lo, float hi) { const bf16x2_cv v = __builtin_convertvector((f32x2_cv){lo, hi}, bf16x2_cv); return __builtin_bit_cast(unsigned, v); }
typedef float f32x2 __attribute__((ext_vector_type(2)));
__device__ __forceinline__ f32x2 gelu_pk(f32x2 v) {
    const f32x2 av = __builtin_elementwise_abs(v), d = av * 0.2316418882f + 1.0f;
    f32x2 t; t.x = __builtin_amdgcn_rcpf(d.x); t.y = __builtin_amdgcn_rcpf(d.y);
    f32x2 q = t * 0.5307027145f + (-0.7265760135f); q = q * t + 0.7107068705f; q = q * t + (-0.142248368f); q = q * t + 0.127414796f; q = q * t;
    const f32x2 s = (v * v) * (-0.72134752044f);
    f32x2 e; e.x = __builtin_amdgcn_exp2f(s.x); e.y = __builtin_amdgcn_exp2f(s.y);
    const f32x2 m = v * (q * e), r = v - m;
    f32x2 o; o.x = v.x < 0.f ? m.x : r.x; o.y = v.y < 0.f ? m.y : r.y; return o;
}

template <int ACT  > struct EpiBf16 {
    static constexpr bool PERM = true, AFTER_DRAIN = false; static_assert(ACT == 0 || ACT == 1, "EpiBf16: ACT is 0 (none) or 1 (gelu_pk)");
    bf16_t* O; int ldc; const float* bias; int split_cols; size_t split_stride; float scale0;
    __device__ __forceinline__ void operator()(const f32x4 (&acc)[2][2][4][2], const Unit& u, int wr, int wc, int fr, int fq) const {
        const int row0 = u.pm * BM + wr * 64 + fr; int colt = u.pn * BM; bf16_t* base = O;
        float sc = 1.f; if (split_cols) { const int t = colt / split_cols; base += (size_t)t * split_stride; colt -= t * split_cols; if (t == 0) sc = scale0; }
        const int col0 = colt + wc * 32 + 8 * fq, bcol0 = u.pn * BM + wc * 32 + 8 * fq;
        f32x4 bv[2][2];
#pragma unroll
        for (int bj = 0; bj < 2; ++bj)
#pragma unroll
            for (int n = 0; n < 2; ++n) bv[bj][n] = bias ? *(const f32x4*)(bias + bcol0 + bj * HALF + 4 * n) : (f32x4){0.f, 0.f, 0.f, 0.f};
#pragma unroll
        for (int ai = 0; ai < 2; ++ai)
#pragma unroll
            for (int m = 0; m < 4; ++m) { bf16_t* rowp = base + (size_t)(row0 + ai * HALF + m * 16) * ldc + col0;
#pragma unroll
                for (int bj = 0; bj < 2; ++bj) { f32x4 v0 = acc[ai][bj][m][0] + bv[bj][0], v1 = acc[ai][bj][m][1] + bv[bj][1];
                    if (ACT == 1) { f32x2 a = gelu_pk((f32x2){v0[0], v0[1]}), b = gelu_pk((f32x2){v0[2], v0[3]}), c = gelu_pk((f32x2){v1[0], v1[1]}), d = gelu_pk((f32x2){v1[2], v1[3]});
                        v0 = (f32x4){a.x, a.y, b.x, b.y}; v1 = (f32x4){c.x, c.y, d.x, d.y}; }
                    v0 = v0 * sc; v1 = v1 * sc; u32x4 w; w.x = cvt_pk_bf16(v0[0], v0[1]); w.y = cvt_pk_bf16(v0[2], v0[3]); w.z = cvt_pk_bf16(v1[0], v1[1]); w.w = cvt_pk_bf16(v1[2], v1[3]);
                    *(u32x4*)(rowp + bj * HALF) = w; } }
    }
};

struct PanelStats {
    unsigned* xbuf;
    unsigned* cnt;
    unsigned* tmo;
    int ntn; float eps;
    unsigned code;
    __device__ __forceinline__ bool run(const f32x4 (&v)[2][2][4][2], const Unit& u, int wr, int wc, int fr, int fq, PG8_LAS unsigned char* lds, int wid, int lane) const {
        typedef float f32x2v __attribute__((ext_vector_type(2)));
        PG8_LAS f32x2v* P = (PG8_LAS f32x2v*)lds;
        PG8_LAS f32x2v* S = (PG8_LAS f32x2v*)(lds + 8192);
        PG8_LAS unsigned* flag = (PG8_LAS unsigned*)(lds + 8192 + 2048);
#pragma unroll
        for (int ai = 0; ai < 2; ++ai)
#pragma unroll
            for (int m = 0; m < 4; ++m) {
                float s = 0.f;
#pragma unroll
                for (int bj = 0; bj < 2; ++bj)
#pragma unroll
                    for (int n = 0; n < 2; ++n) { const f32x4 x = v[ai][bj][m][n]; s += (x[0] + x[1]) + (x[2] + x[3]); }
                s += __shfl_xor(s, 16); s += __shfl_xor(s, 32);
                const float mw = s * (1.0f / 64.0f); float q = 0.f;
#pragma unroll
                for (int bj = 0; bj < 2; ++bj)
#pragma unroll
                    for (int n = 0; n < 2; ++n) { const f32x4 d = v[ai][bj][m][n] - mw; q += (d[0] * d[0] + d[1] * d[1]) + (d[2] * d[2] + d[3] * d[3]); }
                q += __shfl_xor(q, 16); q += __shfl_xor(q, 32);
                if (fq == 0) P[(ai * HALF + wr * 64 + m * 16 + fr) * 4 + wc] = (f32x2v){mw, q};
            }
        asm volatile("s_waitcnt lgkmcnt(0)" ::: "memory"); __builtin_amdgcn_s_barrier(); asm volatile("" ::: "memory");
#if defined(BROKEN_EXCHANGE_NO_WAIT)
#warning BROKEN CONTROL BUILD: the row-statistics exchange does not wait; results are wrong by design
        if (blockIdx.x >= 64) { const long long t0_ = clock64(); while (clock64() - t0_ < 60000) __builtin_amdgcn_s_sleep(8); }
#endif
        const int row = wid * 32 + (lane & 31);
        if (lane < 32) {
            const f32x2v a = P[row * 4 + 0], b = P[row * 4 + 1], c = P[row * 4 + 2], d = P[row * 4 + 3];
            const float mt = (a.x + b.x + c.x + d.x) * 0.25f;
            const float da = a.x - mt, db = b.x - mt, dc = c.x - mt, dd = d.x - mt;
            const float m2 = (a.y + b.y) + (c.y + d.y) + 64.0f * ((da * da + db * db) + (dc * dc + dd * dd));
            unsigned long long* slot = (unsigned long long*)xbuf + ((size_t)(u.pm * BM + row) * 4 + u.pn);
            __hip_atomic_store(slot, ((unsigned long long)__float_as_uint(m2) << 32) | __float_as_uint(mt), __ATOMIC_RELAXED, __HIP_MEMORY_SCOPE_AGENT);
        }
        asm volatile("s_waitcnt vmcnt(0)" ::: "memory");
        if (lane == 0) __hip_atomic_fetch_add(cnt + 64 * u.pm, 1u, __ATOMIC_RELAXED, __HIP_MEMORY_SCOPE_AGENT);
        if (wid == 0) {
            bool dead = false; const unsigned long long t0 = __builtin_amdgcn_s_memrealtime(); const unsigned want = 8u * (unsigned)ntn;
            for (;;) {
#if defined(BROKEN_EXCHANGE_NO_WAIT)
                break;
#endif
                if ((unsigned)__builtin_amdgcn_readfirstlane(__hip_atomic_load(cnt + 64 * u.pm, __ATOMIC_RELAXED, __HIP_MEMORY_SCOPE_AGENT)) >= want) break;
                if (__builtin_amdgcn_s_memrealtime() - t0 > 2000000ull) {
                    if (lane == 0) { unsigned expect = 0u; __hip_atomic_compare_exchange_strong(tmo + 1, &expect, code | (unsigned)(u.pm & 0xff), __ATOMIC_RELAXED, __ATOMIC_RELAXED, __HIP_MEMORY_SCOPE_AGENT);
                                     __hip_atomic_store(tmo, 1u, __ATOMIC_RELAXED, __HIP_MEMORY_SCOPE_AGENT); }
                    dead = true; break; }
                __builtin_amdgcn_s_sleep(2);
            }
            __builtin_amdgcn_fence(__ATOMIC_ACQUIRE, "agent");
            if (lane == 0) flag[0] = dead ? 1u : 0u;
        }
        asm volatile("s_waitcnt vmcnt(0) lgkmcnt(0)" ::: "memory"); __builtin_amdgcn_s_barrier(); asm volatile("" ::: "memory");
        const bool bad = flag[0] != 0u;
        if (lane < 32) {
            const unsigned long long* slot = (const unsigned long long*)xbuf + (size_t)(u.pm * BM + row) * 4; float mt[4], m2[4]; float ms = 0.f;
#pragma unroll
            for (int t = 0; t < 4; ++t) { if (t < ntn) { const unsigned long long w = __hip_atomic_load(slot + t, __ATOMIC_RELAXED, __HIP_MEMORY_SCOPE_AGENT); mt[t] = __uint_as_float((unsigned)w); m2[t] = __uint_as_float((unsigned)(w >> 32)); } else { mt[t] = 0.f; m2[t] = 0.f; } ms += mt[t]; }
            const float mean = ms / (float)ntn; float q = 0.f;
#pragma unroll
            for (int t = 0; t < 4; ++t) if (t < ntn) { const float dm = mt[t] - mean; q += m2[t] + 256.0f * dm * dm; }
            S[row] = (f32x2v){mean, 1.0f / sqrtf(q / (256.0f * (float)ntn) + eps)};
        }
        asm volatile("s_waitcnt lgkmcnt(0)" ::: "memory"); __builtin_amdgcn_s_barrier(); asm volatile("" ::: "memory");
        return bad;
    }
};
struct EpiLnRes {
    static constexpr bool PERM = false, AFTER_DRAIN = true;
    const float* base; float* out; int ldc; const float* bias; PanelStats st; unsigned poison;
    __device__ __forceinline__ void fused(f32x4 (&acc)[2][2][4][2], const Unit& u, int wr, int wc, int fr, int fq, PG8_LAS unsigned char* lds, int wid, int lane) const {
        typedef float f32x2v __attribute__((ext_vector_type(2)));
        const PG8_LAS f32x2v* S = (const PG8_LAS f32x2v*)(lds + 8192);
        const int col0 = u.pn * BM + wc * 32 + 4 * fq;
#pragma unroll
        for (int bj = 0; bj < 2; ++bj)
#pragma unroll
            for (int n = 0; n < 2; ++n) { const f32x4 bv = bias ? *(const f32x4*)(bias + col0 + bj * HALF + n * 16) : (f32x4){0.f, 0.f, 0.f, 0.f};
#pragma unroll
                for (int ai = 0; ai < 2; ++ai)
#pragma unroll
                    for (int m = 0; m < 4; ++m) acc[ai][bj][m][n] += bv; }
        f32x4 pre[4][2][2];
#pragma unroll
        for (int m = 0; m < 4; ++m) { const size_t off = (size_t)(u.pm * BM + wr * 64 + m * 16 + fr) * ldc + col0;
#pragma unroll
            for (int bj = 0; bj < 2; ++bj)
#pragma unroll
                for (int n = 0; n < 2; ++n) pre[m][bj][n] = *(const f32x4*)(base + off + bj * HALF + n * 16); }
        const bool bad = st.run(acc, u, wr, wc, fr, fq, lds, wid, lane) || poison != 0u;
        const float qnan = __builtin_nanf("");
#pragma unroll
        for (int ai = 0; ai < 2; ++ai)
#pragma unroll
            for (int m = 0; m < 4; ++m) { const int r = ai * HALF + wr * 64 + m * 16 + fr; const f32x2v sr = S[r]; const size_t off = (size_t)(u.pm * BM + r) * ldc + col0;
#pragma unroll
                for (int bj = 0; bj < 2; ++bj)
#pragma unroll
                    for (int n = 0; n < 2; ++n) { const f32x4 bs = ai == 0 ? pre[m][bj][n] : *(const f32x4*)(base + off + bj * HALF + n * 16); f32x4 o = bs + (acc[ai][bj][m][n] - sr.x) * sr.y;
                        if (bad) o = (f32x4){qnan, qnan, qnan, qnan}; *(f32x4*)(out + off + bj * HALF + n * 16) = o; }
                if (m & 1) asm volatile("" ::: "memory"); }
    }
};
struct EpiLnResLn {
    static constexpr bool PERM = false, AFTER_DRAIN = true;
    const float* base; float* out; bf16_t* xn; int ldc; const float* bias; PanelStats st1, st2; unsigned poison;
    __device__ __forceinline__ void fused(f32x4 (&acc)[2][2][4][2], const Unit& u, int wr, int wc, int fr, int fq, PG8_LAS unsigned char* lds, int wid, int lane) const {
        typedef float f32x2v __attribute__((ext_vector_type(2))); typedef unsigned u32x2v __attribute__((ext_vector_type(2)));
        const PG8_LAS f32x2v* S = (const PG8_LAS f32x2v*)(lds + 8192);
        const int col0 = u.pn * BM + wc * 32 + 4 * fq;
#pragma unroll
        for (int bj = 0; bj < 2; ++bj)
#pragma unroll
            for (int n = 0; n < 2; ++n) { const f32x4 bv = bias ? *(const f32x4*)(bias + col0 + bj * HALF + n * 16) : (f32x4){0.f, 0.f, 0.f, 0.f};
#pragma unroll
                for (int ai = 0; ai < 2; ++ai)
#pragma unroll
                    for (int m = 0; m < 4; ++m) acc[ai][bj][m][n] += bv; }
        bool bad = st1.run(acc, u, wr, wc, fr, fq, lds, wid, lane) || poison != 0u;
        const float qnan = __builtin_nanf("");
#pragma unroll
        for (int ai = 0; ai < 2; ++ai)
#pragma unroll
            for (int m = 0; m < 4; ++m) { const int r = ai * HALF + wr * 64 + m * 16 + fr; const f32x2v sr = S[r]; const size_t off = (size_t)(u.pm * BM + r) * ldc + col0;
#pragma unroll
                for (int bj = 0; bj < 2; ++bj)
#pragma unroll
                    for (int n = 0; n < 2; ++n) { const f32x4 bs = *(const f32x4*)(base + off + bj * HALF + n * 16); acc[ai][bj][m][n] = bs + (acc[ai][bj][m][n] - sr.x) * sr.y; }
                asm volatile("" : "+v"(acc[ai][0][m][0]), "+v"(acc[ai][0][m][1]), "+v"(acc[ai][1][m][0]), "+v"(acc[ai][1][m][1]));
                if (m & 1) asm volatile("" ::: "memory"); }
        const bool bad1 = bad;
        bad = st2.run(acc, u, wr, wc, fr, fq, lds, wid, lane) || bad;
#pragma unroll
        for (int ai = 0; ai < 2; ++ai)
#pragma unroll
            for (int m = 0; m < 4; ++m) { const int r = ai * HALF + wr * 64 + m * 16 + fr; const f32x2v sr = S[r]; const size_t off = (size_t)(u.pm * BM + r) * ldc + col0;
#pragma unroll
                for (int bj = 0; bj < 2; ++bj)
#pragma unroll
                    for (int n = 0; n < 2; ++n) { const f32x4 x1 = acc[ai][bj][m][n]; *(f32x4*)(out + off + bj * HALF + n * 16) = bad1 ? (f32x4){qnan, qnan, qnan, qnan} : x1;
                        const f32x4 o = (x1 - sr.x) * sr.y; u32x2v w; w.x = cvt_pk_bf16(o[0], o[1]); w.y = cvt_pk_bf16(o[2], o[3]);
                        if (bad) { w.x = 0x7fc07fc0u; w.y = 0x7fc07fc0u; } *(u32x2v*)(xn + off + bj * HALF + n * 16) = w; }
                asm volatile("" ::: "memory"); }
    }
};

template <class Epi, class Sched, bool ALIGN_EPI = false, bool SP2 = false>
__device__ __forceinline__ void gemm_phase(PG8_LAS unsigned char* lds, const Gemm g, const Sched& S, const Epi& E) {
    const int tid = threadIdx.x, wid = __builtin_amdgcn_readfirstlane(tid >> 6), lane = tid & 63, wr = wid >> 2, wc = wid & 3, fr = lane & 15, fq = lane >> 4;
    const int K = g.K, nt = K / BK;
    unsigned voffA[2], voffB[2];
#pragma unroll
    for (int i = 0; i < 2; ++i) { int R, C; stage_rc(tid * 16 + i * 8192, R, C); const int Rb = Epi::PERM ? ((R & ~31) + perm32(R & 31)) : R;
        voffA[i] = (unsigned)(R * K + C) * 2u; voffB[i] = (unsigned)(Rb * K + C) * 2u; }
    const size_t kstep = (size_t)(BK * 2);
    const size_t hstep = (size_t)HALF * K * 2;
    const size_t tstep = 2 * hstep;
    const unsigned ldsw = (unsigned)wid * 1024u;
    const int aoff = lds_byte(wr * 64 + fr, fq * 8), boff = lds_byte(wc * 32 + fr, fq * 8);
#define PG8_SA(b, h) (((b) * 2 + (h)) * HTB)
#define PG8_SB(b, h) ((4 + (b) * 2 + (h)) * HTB)
#define PG8_STAGE(bufoff, gbase, voff) do { _Pragma("unroll") for (int _i = 0; _i < 2; ++_i) \
        __builtin_amdgcn_global_load_lds((const unsigned*)((const char*)(gbase) + (voff)[_i]), (PG8_LAS unsigned*)(lds + (bufoff) + ldsw + _i * 8192), 16, 0, 0); } while (0)
#define PG8_LDA(dst, b, h) do { _Pragma("unroll") for (int m = 0; m < 4; ++m) _Pragma("unroll") for (int k = 0; k < 2; ++k) dst[m][k] = *(const PG8_LAS bf16x8*)(lds + PG8_SA(b, h) + aoff + m * 2048 + k * 1024); } while (0)
#define PG8_LDB(dst, b, h) do { _Pragma("unroll") for (int n = 0; n < 2; ++n) _Pragma("unroll") for (int k = 0; k < 2; ++k) dst[n][k] = *(const PG8_LAS bf16x8*)(lds + PG8_SB(b, h) + boff + n * 2048 + k * 1024); } while (0)
#define PG8_MMA(ai, bj, At, Bt) do { __builtin_amdgcn_s_setprio(1); _Pragma("unroll") for (int m = 0; m < 4; ++m) _Pragma("unroll") for (int n = 0; n < 2; ++n) _Pragma("unroll") for (int k = 0; k < 2; ++k) \
        acc[ai][bj][m][n] = __builtin_amdgcn_mfma_f32_16x16x32_bf16(Bt[n][k], At[m][k], acc[ai][bj][m][n], 0, 0, 0); __builtin_amdgcn_s_setprio(0); } while (0)
#define PG8_WAIT_V(n) asm volatile("s_waitcnt vmcnt(" #n ")" ::: "memory")
#define PG8_WAIT_L(n) asm volatile("s_waitcnt lgkmcnt(" #n ")" ::: "memory")
#define PG8_BAR __builtin_amdgcn_s_barrier()
#define PG8_SCHED __builtin_amdgcn_sched_barrier(0)
    Unit cur, nxt; int ui = 0;
    if (!S.next(0, cur)) return;
    f32x4 acc[2][2][4][2];
#pragma unroll
    for (int a = 0; a < 2; ++a)
#pragma unroll
        for (int b = 0; b < 2; ++b)
#pragma unroll
            for (int m = 0; m < 4; ++m)
#pragma unroll
                for (int n = 0; n < 2; ++n) acc[a][b][m][n] = (f32x4){0.f, 0.f, 0.f, 0.f};
    bf16x8 At[4][2], B0[2][2], B1[2][2];
    const char* cA = (const char*)g.A + (size_t)cur.pm * tstep; const char* cB = (const char*)g.Bt + (size_t)cur.pn * tstep;
    S.a_ready(cur);
    if constexpr (SP2) {
        PG8_STAGE(PG8_SB(0, 0), cB, voffB); PG8_STAGE(PG8_SB(0, 1), cB + hstep, voffB); PG8_STAGE(PG8_SA(0, 0), cA, voffA); PG8_STAGE(PG8_SA(0, 1), cA + hstep, voffA);
        if (wr == 1) PG8_BAR;
        PG8_WAIT_V(2); PG8_BAR;
        PG8_STAGE(PG8_SB(1, 0), cB + kstep, voffB); PG8_STAGE(PG8_SA(1, 0), cA + kstep, voffA); PG8_STAGE(PG8_SB(1, 1), cB + hstep + kstep, voffB);
        PG8_WAIT_V(6); PG8_BAR;
    } else {
        PG8_STAGE(PG8_SB(0, 0), cB, voffB); PG8_STAGE(PG8_SA(0, 0), cA, voffA); PG8_STAGE(PG8_SB(0, 1), cB + hstep, voffB); PG8_STAGE(PG8_SA(0, 1), cA + hstep, voffA);
        if (wr == 1) PG8_BAR;
        PG8_WAIT_V(4); PG8_BAR;
        PG8_STAGE(PG8_SB(1, 0), cB + kstep, voffB); PG8_STAGE(PG8_SA(1, 0), cA + kstep, voffA); PG8_STAGE(PG8_SB(1, 1), cB + hstep + kstep, voffB);
        PG8_WAIT_V(6); PG8_BAR;
    }
    for (;;) {
        const bool has_next = S.next(ui + 1, nxt);
        const char* nA = has_next ? (const char*)g.A + (size_t)nxt.pm * tstep : cA; const char* nB = has_next ? (const char*)g.Bt + (size_t)nxt.pn * tstep : cB;
        for (int t = 0; t < nt; t += 2) {
            const bool last = (t == nt - 2);
            const char* a1 = cA + (size_t)(t + 1) * kstep;
            const char* a2 = last ? nA : cA + (size_t)(t + 2) * kstep; const char* b2 = last ? nB : cB + (size_t)(t + 2) * kstep;
            const char* a3 = a2 + kstep; const char* b3 = b2 + kstep;
            if (last && has_next) S.a_ready(nxt);
            if constexpr (SP2) {
            PG8_LDB(B0, 0, 0); PG8_LDB(B1, 0, 1); PG8_SCHED; PG8_LDA(At, 0, 0); PG8_STAGE(PG8_SA(1, 1), a1 + hstep, voffA);
            PG8_WAIT_V(8); PG8_WAIT_L(0); PG8_BAR; PG8_MMA(0, 0, At, B0); PG8_MMA(0, 1, At, B1); PG8_BAR; PG8_SCHED;
            PG8_LDA(At, 0, 1); PG8_STAGE(PG8_SB(0, 0), b2, voffB); PG8_STAGE(PG8_SB(0, 1), b2 + hstep, voffB); PG8_STAGE(PG8_SA(0, 0), a2, voffA);
            PG8_WAIT_V(8); PG8_WAIT_L(0); PG8_BAR; PG8_MMA(1, 0, At, B0); PG8_MMA(1, 1, At, B1); PG8_BAR; PG8_SCHED;
            PG8_LDB(B0, 1, 0); PG8_LDB(B1, 1, 1); PG8_SCHED; PG8_LDA(At, 1, 0); PG8_STAGE(PG8_SA(0, 1), a2 + hstep, voffA);
            PG8_WAIT_V(8); PG8_WAIT_L(0); PG8_BAR; PG8_MMA(0, 0, At, B0); PG8_MMA(0, 1, At, B1); PG8_BAR; PG8_SCHED;
            PG8_LDA(At, 1, 1); PG8_STAGE(PG8_SB(1, 0), b3, voffB); PG8_STAGE(PG8_SB(1, 1), b3 + hstep, voffB); PG8_STAGE(PG8_SA(1, 0), a3, voffA);
            PG8_WAIT_V(8); PG8_WAIT_L(0); PG8_BAR; PG8_MMA(1, 0, At, B0); PG8_MMA(1, 1, At, B1); PG8_BAR; PG8_SCHED;
            } else {
            PG8_LDB(B0, 0, 0); PG8_SCHED; PG8_LDA(At, 0, 0); PG8_STAGE(PG8_SA(1, 1), a1 + hstep, voffA);
            PG8_WAIT_L(8); PG8_BAR; PG8_WAIT_L(0); PG8_MMA(0, 0, At, B0); PG8_BAR; PG8_SCHED;
            PG8_LDB(B1, 0, 1); PG8_STAGE(PG8_SB(0, 0), b2, voffB);
            PG8_BAR; PG8_WAIT_L(0); PG8_MMA(0, 1, At, B1); PG8_BAR;
            PG8_LDA(At, 0, 1); PG8_STAGE(PG8_SA(0, 0), a2, voffA);
            PG8_BAR; PG8_WAIT_L(0); PG8_MMA(1, 0, At, B0); PG8_BAR; PG8_SCHED;
            PG8_STAGE(PG8_SB(0, 1), b2 + hstep, voffB);
            PG8_WAIT_V(6); PG8_BAR; PG8_MMA(1, 1, At, B1); PG8_BAR;
            PG8_LDB(B0, 1, 0); PG8_SCHED; PG8_LDA(At, 1, 0); PG8_STAGE(PG8_SA(0, 1), a2 + hstep, voffA);
            PG8_WAIT_L(8); PG8_BAR; PG8_WAIT_L(0); PG8_MMA(0, 0, At, B0); PG8_BAR; PG8_SCHED;
            PG8_LDB(B1, 1, 1); PG8_STAGE(PG8_SB(1, 0), b3, voffB);
            PG8_BAR; PG8_WAIT_L(0); PG8_MMA(0, 1, At, B1); PG8_BAR;
            PG8_LDA(At, 1, 1); PG8_STAGE(PG8_SA(1, 0), a3, voffA);
            PG8_BAR; PG8_WAIT_L(0); PG8_MMA(1, 0, At, B0); PG8_BAR; PG8_SCHED;
            PG8_STAGE(PG8_SB(1, 1), b3 + hstep, voffB);
            PG8_WAIT_V(6); PG8_BAR; PG8_MMA(1, 1, At, B1); PG8_BAR;
            }
        }
        if constexpr (ALIGN_EPI) { if (wr == 0) PG8_BAR; }
        if constexpr (!Epi::AFTER_DRAIN) { E(acc, cur, wr, wc, fr, fq); S.done(cur); }
        if (!has_next) break;
#pragma unroll
        for (int a = 0; a < 2; ++a)
#pragma unroll
            for (int b = 0; b < 2; ++b)
#pragma unroll
                for (int m = 0; m < 4; ++m)
#pragma unroll
                    for (int n = 0; n < 2; ++n) acc[a][b][m][n] = (f32x4){0.f, 0.f, 0.f, 0.f};
        cur = nxt; cA = nA; cB = nB; ++ui;
        if constexpr (ALIGN_EPI) { if (wr == 1) PG8_BAR; }
    }
    PG8_WAIT_V(0);
    if constexpr (!ALIGN_EPI) { if (wr == 0) PG8_BAR; }
    PG8_BAR;
    if constexpr (Epi::AFTER_DRAIN) { E.fused(acc, cur, wr, wc, fr, fq, lds, wid, lane); S.done(cur); }
#undef PG8_SA
#undef PG8_SB
#undef PG8_STAGE
#undef PG8_LDA
#undef PG8_LDB
#undef PG8_MMA
#undef PG8_WAIT_V
#undef PG8_WAIT_L
#undef PG8_BAR
#undef PG8_SCHED
}
}

namespace pg8 {
constexpr float RMS_EPS = 1e-6f;
__device__ __forceinline__ float row_rstd(const float* ss, int row) {
    const f32x4* p = (const f32x4*)(ss + (size_t)row * 16); const f32x4 a = p[0], b = p[1], c = p[2], d = p[3];
    const float s = (((a[0] + a[1]) + (a[2] + a[3])) + ((b[0] + b[1]) + (b[2] + b[3]))) + (((c[0] + c[1]) + (c[2] + c[3])) + ((d[0] + d[1]) + (d[2] + d[3])));
    return 1.0f / sqrtf(s * (1.0f / 1024.0f) + RMS_EPS);
}
__device__ __forceinline__ float silu_f(float g) { return g * __builtin_amdgcn_rcpf(1.0f + __builtin_amdgcn_exp2f(-1.4426950408889634f * g)); }
struct EpiSwiGLU {
    static constexpr bool PERM = true, AFTER_DRAIN = false;
    bf16_t* H; int ldh; const float* ss;
    __device__ __forceinline__ void operator()(const f32x4 (&acc)[2][2][4][2], const Unit& u, int wr, int wc, int fr, int fq) const {
        const int row0 = u.pm * BM + wr * 64 + fr, col0 = u.pn * 128 + wc * 32 + 8 * fq;
#pragma unroll
        for (int ai = 0; ai < 2; ++ai)
#pragma unroll
            for (int m = 0; m < 4; ++m) { const int row = row0 + ai * HALF + m * 16; const float rs = row_rstd(ss, row);
                float h[8];
#pragma unroll
                for (int n = 0; n < 2; ++n)
#pragma unroll
                    for (int e = 0; e < 4; ++e) { const float g = acc[ai][0][m][n][e] * rs, up = acc[ai][1][m][n][e] * rs; h[n * 4 + e] = silu_f(g) * up; }
                u32x4 w; w.x = cvt_pk_bf16(h[0], h[1]); w.y = cvt_pk_bf16(h[2], h[3]); w.z = cvt_pk_bf16(h[4], h[5]); w.w = cvt_pk_bf16(h[6], h[7]);
                *(u32x4*)(H + (size_t)row * ldh + col0) = w; }
    }
};
struct EpiProj {
    static constexpr bool PERM = true, AFTER_DRAIN = false;
    bf16_t* PA; bf16_t* PR; const float* ss;
    __device__ __forceinline__ void operator()(const f32x4 (&acc)[2][2][4][2], const Unit& u, int wr, int wc, int fr, int fq) const {
        const int row0 = u.pm * BM + wr * 64 + fr; const int cin = wc * 32 + 8 * fq;
        bf16_t* base; int ld;
        if (u.pn < 4) { base = PA + u.pn * 256 + cin; ld = 1024; } else { base = PR + (u.pn - 4) * 256 + cin; ld = 2560; }
#pragma unroll
        for (int ai = 0; ai < 2; ++ai)
#pragma unroll
            for (int m = 0; m < 4; ++m) { const int row = row0 + ai * HALF + m * 16; const float rs = row_rstd(ss, row);
#pragma unroll
                for (int bj = 0; bj < 2; ++bj) { const f32x4 v0 = acc[ai][bj][m][0] * rs, v1 = acc[ai][bj][m][1] * rs;
                    u32x4 w; w.x = cvt_pk_bf16(v0[0], v0[1]); w.y = cvt_pk_bf16(v0[2], v0[3]); w.z = cvt_pk_bf16(v1[0], v1[1]); w.w = cvt_pk_bf16(v1[2], v1[3]);
                    *(u32x4*)(base + (size_t)row * ld + bj * HALF) = w; } }
    }
};
template <bool BASE_BF16, bool OUT_F32> struct EpiResid {
    static constexpr bool PERM = true, AFTER_DRAIN = false;
    const void* base; void* out; float* ss; float scale;
    __device__ __forceinline__ void operator()(const f32x4 (&acc)[2][2][4][2], const Unit& u, int wr, int wc, int fr, int fq) const {
        const int row0 = u.pm * BM + wr * 64 + fr, col0 = u.pn * BM + wc * 32 + 8 * fq;
#pragma unroll
        for (int ai = 0; ai < 2; ++ai)
#pragma unroll
            for (int m = 0; m < 4; ++m) { const int row = row0 + ai * HALF + m * 16; const size_t off = (size_t)row * 1024 + col0; float sq = 0.f;
#pragma unroll
                for (int bj = 0; bj < 2; ++bj) {
                    f32x4 b0, b1;
                    if (BASE_BF16) { const u32x4 r = *(const u32x4*)((const bf16_t*)base + off + bj * HALF);
                        b0 = (f32x4){__uint_as_float(r.x << 16), __uint_as_float(r.x & 0xffff0000u), __uint_as_float(r.y << 16), __uint_as_float(r.y & 0xffff0000u)};
                        b1 = (f32x4){__uint_as_float(r.z << 16), __uint_as_float(r.z & 0xffff0000u), __uint_as_float(r.w << 16), __uint_as_float(r.w & 0xffff0000u)}; }
                    else { b0 = *(const f32x4*)((const float*)base + off + bj * HALF); b1 = *(const f32x4*)((const float*)base + off + bj * HALF + 4); }
                    const f32x4 v0 = b0 + acc[ai][bj][m][0] * scale, v1 = b1 + acc[ai][bj][m][1] * scale;
                    sq += ((v0[0] * v0[0] + v0[1] * v0[1]) + (v0[2] * v0[2] + v0[3] * v0[3])) + ((v1[0] * v1[0] + v1[1] * v1[1]) + (v1[2] * v1[2] + v1[3] * v1[3]));
                    if (OUT_F32) { *(f32x4*)((float*)out + off + bj * HALF) = v0; *(f32x4*)((float*)out + off + bj * HALF + 4) = v1; }
                    else { u32x4 w; w.x = cvt_pk_bf16(v0[0], v0[1]); w.y = cvt_pk_bf16(v0[2], v0[3]); w.z = cvt_pk_bf16(v1[0], v1[1]); w.w = cvt_pk_bf16(v1[2], v1[3]);
                        *(u32x4*)((bf16_t*)out + off + bj * HALF) = w; } }
                if (ss) { sq += __shfl_xor(sq, 16); sq += __shfl_xor(sq, 32); if (fq == 0) ss[(size_t)row * 16 + u.pn * 4 + wc] = sq; } }
    }
};
}

namespace att {
using bf16 = __hip_bfloat16;
constexpr int   D = 128, NW = 8, QBLK = 32, KVBLK = 64;
constexpr float SCALE = 0.088388347648318440f;
constexpr float THR = 8.f;
constexpr int SDEPTH = 2;
constexpr int LDQ = 1024, LDK = 1024, LDO = 512;
constexpr size_t SHM_V = KVBLK * D * 2, SHM_K = KVBLK * D * 2, SHM_ATTN = 2 * SHM_V + 2 * SHM_K + NW * 64 * 4;
using bf16x8 = __attribute__((ext_vector_type(8))) short;
using s16x4  = __attribute__((ext_vector_type(4))) short;
using f32x16 = __attribute__((ext_vector_type(16))) float;
using f32x8  = __attribute__((ext_vector_type(8))) float;
using u32x4  = __attribute__((ext_vector_type(4))) unsigned;
#define KSWZ(row, colB) ((row) * 256 + ((colB) ^ (((row) & 7) << 4)))
#define SBAR() __builtin_amdgcn_sched_barrier(0)
__device__ __forceinline__ int crow(int r, int hi) { return (r & 3) + 8 * (r >> 2) + 4 * hi; }
__device__ __forceinline__ unsigned cvtpk(float lo, float hi) {
  unsigned r; asm volatile("v_cvt_pk_bf16_f32 %0, %1, %2" : "=v"(r) : "v"(lo), "v"(hi)); return r;
}
template <typename TIn> struct Stage;
template <> struct Stage<bf16>  { using T = bf16x8;
  __device__ static __forceinline__ T ld8(const bf16* p) { return *reinterpret_cast<const bf16x8*>(p); }
  __device__ static __forceinline__ bf16x8 tobf(T x) { return x; } };
template <> struct Stage<float> { using T = f32x8;
  __device__ static __forceinline__ T ld8(const float* p) { return *reinterpret_cast<const f32x8*>(p); }
  __device__ static __forceinline__ bf16x8 tobf(T x) {
    u32x4 w = {cvtpk(x[0], x[1]), cvtpk(x[2], x[3]), cvtpk(x[4], x[5]), cvtpk(x[6], x[7])}; return *reinterpret_cast<bf16x8*>(&w); } };

__device__ __forceinline__ void partialSM(f32x16& p0, f32x16& p1, float& m_reg, float& mn, float& alpha) {
  constexpr float C = SCALE * 1.4426950408889634f;
  float pmax = p0[0]; for (int r = 1; r < 16; ++r) pmax = fmaxf(pmax, p0[r]); for (int r = 0; r < 16; ++r) pmax = fmaxf(pmax, p1[r]);
  { auto rr = __builtin_amdgcn_permlane32_swap(__float_as_uint(pmax), __float_as_uint(pmax), false, false);
    pmax = fmaxf(__uint_as_float(rr[0]), __uint_as_float(rr[1])); }
  if (__builtin_expect(__all(pmax - m_reg <= THR / SCALE), 1)) { mn = m_reg; alpha = 1.f; }
  else { mn = fmaxf(m_reg, pmax); alpha = __builtin_amdgcn_exp2f((m_reg - mn) * C); m_reg = mn; }
  float mnC = -mn * C;
  for (int r = 0; r < 16; ++r) p0[r] = fmaf(p0[r], C, mnC); for (int r = 0; r < 16; ++r) p1[r] = fmaf(p1[r], C, mnC);
  for (int r = 0; r < 16; ++r) p0[r] = __builtin_amdgcn_exp2f(p0[r]);
}
__device__ __forceinline__ void finishSM(f32x16& p0, f32x16& p1, float alpha, float& l_reg, bf16x8& pa0, bf16x8& pa1, bf16x8& pa2, bf16x8& pa3) {
  for (int r = 0; r < 16; ++r) p1[r] = __builtin_amdgcn_exp2f(p1[r]);
  float ps = 0; for (int r = 0; r < 16; ++r) ps += p0[r]; for (int r = 0; r < 16; ++r) ps += p1[r];
  { auto rr = __builtin_amdgcn_permlane32_swap(__float_as_uint(ps), __float_as_uint(ps), false, false);
    ps = __uint_as_float(rr[0]) + __uint_as_float(rr[1]); }
  l_reg = l_reg * alpha + ps;
#define PK4(P, BASE, OUT) do { unsigned a0 = cvtpk(P[BASE + 0], P[BASE + 1]), a1 = cvtpk(P[BASE + 2], P[BASE + 3]);   \
    unsigned b0 = cvtpk(P[BASE + 4], P[BASE + 5]), b1 = cvtpk(P[BASE + 6], P[BASE + 7]);                              \
    auto r0 = __builtin_amdgcn_permlane32_swap(a0, b0, false, false); auto r1 = __builtin_amdgcn_permlane32_swap(a1, b1, false, false); \
    u32x4 w = {r0[0], r1[0], r0[1], r1[1]}; OUT = *reinterpret_cast<bf16x8*>(&w); } while (0)
  PK4(p0, 0, pa0); PK4(p0, 8, pa1); PK4(p1, 0, pa2); PK4(p1, 8, pa3);
#undef PK4
}
__device__ __forceinline__ void qkt(f32x16& p0, f32x16& p1, const bf16* Ks, const bf16x8* qr, int r32, int hi) {
  p0 = f32x16{}; p1 = f32x16{};
  for (int d0 = 0; d0 < 8; ++d0) { int cb = (d0 * 16 + hi * 8) * 2;
    bf16x8 b0 = *reinterpret_cast<const bf16x8*>((const char*)Ks + KSWZ(r32, cb));
    bf16x8 b1 = *reinterpret_cast<const bf16x8*>((const char*)Ks + KSWZ(32 + r32, cb));
    p0 = __builtin_amdgcn_mfma_f32_32x32x16_bf16(b0, qr[d0], p0, 0, 0, 0);
    p1 = __builtin_amdgcn_mfma_f32_32x32x16_bf16(b1, qr[d0], p1, 0, 0, 0); }
}
__device__ __forceinline__ int v_st(int k, int c) { const int kk = (k & ~0xC) | ((k & 4) << 1) | ((k & 8) >> 1); return ((kk >> 3) * 4 + (c >> 5)) * 512 + ((kk & 7) * 32 + (c & 31)) * 2; }
__device__ __forceinline__ int v_rd_base(int lane) { return ((lane & 3) << 3) | (((lane >> 2) & 3) << 6) | (((lane >> 4) & 1) << 5) | (((lane >> 5) & 1) << 8); }
constexpr int v_rd_off(int d0, int ks, int half) { return d0 * 512 + ks * 4096 + half * 2048; }
template <int OFF> __device__ __forceinline__ s16x4 tr_read(int vb) {
  s16x4 r; asm volatile("ds_read_b64_tr_b16 %0, %1 offset:%2" : "=&v"(r) : "v"(vb), "i"(OFF) : "memory"); return r;
}
template <int D0> __device__ __forceinline__ void pv_one(f32x16& od, int vb, bf16x8 pa0, bf16x8 pa1, bf16x8 pa2, bf16x8 pa3) {
  const s16x4 l0 = tr_read<v_rd_off(D0, 0, 0)>(vb), h0 = tr_read<v_rd_off(D0, 0, 1)>(vb), l1 = tr_read<v_rd_off(D0, 1, 0)>(vb), h1 = tr_read<v_rd_off(D0, 1, 1)>(vb);
  const s16x4 l2 = tr_read<v_rd_off(D0, 2, 0)>(vb), h2 = tr_read<v_rd_off(D0, 2, 1)>(vb), l3 = tr_read<v_rd_off(D0, 3, 0)>(vb), h3 = tr_read<v_rd_off(D0, 3, 1)>(vb);
  asm volatile("s_waitcnt lgkmcnt(0)" ::: "memory"); SBAR();
#define PK(L, H) (bf16x8){L[0], L[1], L[2], L[3], H[0], H[1], H[2], H[3]}
  od = __builtin_amdgcn_mfma_f32_32x32x16_bf16(pa0, PK(l0, h0), od, 0, 0, 0);
  od = __builtin_amdgcn_mfma_f32_32x32x16_bf16(pa1, PK(l1, h1), od, 0, 0, 0);
  od = __builtin_amdgcn_mfma_f32_32x32x16_bf16(pa2, PK(l2, h2), od, 0, 0, 0);
  od = __builtin_amdgcn_mfma_f32_32x32x16_bf16(pa3, PK(l3, h3), od, 0, 0, 0);
#undef PK
}
__device__ __forceinline__ void pv_d0(f32x16* o, int vb, bf16x8 pa0, bf16x8 pa1, bf16x8 pa2, bf16x8 pa3) {
  pv_one<0>(o[0], vb, pa0, pa1, pa2, pa3); pv_one<1>(o[1], vb, pa0, pa1, pa2, pa3); pv_one<2>(o[2], vb, pa0, pa1, pa2, pa3); pv_one<3>(o[3], vb, pa0, pa1, pa2, pa3);
}

template <typename TQ>
__device__ __forceinline__ void attn_dense_body(const TQ* __restrict__ Qb, const bf16* __restrict__ Kh, const bf16* __restrict__ Vh,
                                                float* __restrict__ Ob, int seq, char* lds) {
  using St = Stage<bf16>; using SQ = Stage<TQ>;
  const int tid = threadIdx.x, wid = tid >> 6, lane = tid & 63, r32 = lane & 31, hi = lane >> 5;
  bf16* V_lds = (bf16*)lds; bf16* K_lds = (bf16*)(lds + 2 * SHM_V);
  float* ws = (float*)(lds + 2 * SHM_V + 2 * SHM_K) + wid * 64; float* li_l = ws; float* al_l = ws + 32;
  float m_reg = -1e30f, l_reg = 0; f32x16 o[4] = {}; bf16x8 qr[8];
  const TQ* Qw = Qb + (long)(wid * QBLK + r32) * LDQ + hi * 8;
#pragma unroll
  for (int d0 = 0; d0 < 8; ++d0) qr[d0] = SQ::tobf(SQ::ld8(Qw + d0 * 16));
  const int sr = tid >> 4, sc = (tid & 15) * 8, vst0 = v_st(sr, sc), vst1 = v_st(32 + sr, sc);
  const int vb0 = (int)(uintptr_t)V_lds + v_rd_base(lane);
  struct { typename St::T vs0, vs1, ks0, ks1; } sr_[SDEPTH];
#define SLOAD(i, k0) do { sr_[i].vs0 = St::ld8(&Vh[(long)((k0) + sr) * LDK + sc]); sr_[i].vs1 = St::ld8(&Vh[(long)((k0) + 32 + sr) * LDK + sc]); \
    sr_[i].ks0 = St::ld8(&Kh[(long)((k0) + sr) * LDK + sc]); sr_[i].ks1 = St::ld8(&Kh[(long)((k0) + 32 + sr) * LDK + sc]); } while (0)
#define SWRITE(b, i) do { *(bf16x8*)((char*)V_lds + (b) * SHM_V + vst0) = St::tobf(sr_[i].vs0);          \
    *(bf16x8*)((char*)V_lds + (b) * SHM_V + vst1) = St::tobf(sr_[i].vs1); int kc = sc * 2;               \
    *(bf16x8*)((char*)K_lds + (b) * SHM_K + KSWZ(sr, kc)) = St::tobf(sr_[i].ks0);                       \
    *(bf16x8*)((char*)K_lds + (b) * SHM_K + KSWZ(32 + sr, kc)) = St::tobf(sr_[i].ks1); } while (0)
#define SWAIT() do { if constexpr (SDEPTH == 2) asm volatile("s_waitcnt vmcnt(4)" ::: "memory"); else asm volatile("s_waitcnt vmcnt(0)" ::: "memory"); } while (0)
#define RESC(a) do { if (__any((a) < 1.f)) { if (hi == 0) al_l[r32] = (a); asm volatile("s_waitcnt lgkmcnt(0)" ::: "memory"); \
    for (int d = 0; d < 4; ++d) for (int r = 0; r < 16; ++r) o[d][r] *= al_l[crow(r, hi)]; } } while (0)
  f32x16 pA0, pA1, pB0, pB1; float mnA, mnB, alA, alB; bf16x8 pa0, pa1, pa2, pa3; const int NT = seq / KVBLK;
  constexpr int SE = 0, SO = SDEPTH - 1;
  SLOAD(SE, 0); asm volatile("s_waitcnt vmcnt(0)" ::: "memory"); SWRITE(0, SE); __syncthreads();
  qkt(pA0, pA1, K_lds, qr, r32, hi); partialSM(pA0, pA1, m_reg, mnA, alA);
  SLOAD(SO, KVBLK); if constexpr (SDEPTH == 2) { if (2 < NT) SLOAD(SE, 2 * KVBLK); }
  SWAIT(); SWRITE(1, SO); __syncthreads();
  for (int j = 1; j + 1 < NT; j += 2) {
    SBAR(); qkt(pB0, pB1, (bf16*)((char*)K_lds + SHM_K), qr, r32, hi);
    finishSM(pA0, pA1, alA, l_reg, pa0, pa1, pa2, pa3); SBAR();
    SLOAD(SO, (j + SDEPTH) * KVBLK); SBAR();
    pv_d0(o, vb0, pa0, pa1, pa2, pa3); partialSM(pB0, pB1, m_reg, mnB, alB);
    __syncthreads(); SWAIT(); SWRITE(0, SE);
    RESC(alB); __syncthreads();
    SBAR(); qkt(pA0, pA1, K_lds, qr, r32, hi);
    finishSM(pB0, pB1, alB, l_reg, pa0, pa1, pa2, pa3); SBAR();
    if (SDEPTH == 1 || j + 3 < NT) SLOAD(SE, (j + 1 + SDEPTH) * KVBLK); SBAR();
    pv_d0(o, vb0 + (int)SHM_V, pa0, pa1, pa2, pa3); partialSM(pA0, pA1, m_reg, mnA, alA);
    __syncthreads(); SWAIT(); SWRITE(1, SO);
    RESC(alA); __syncthreads();
  }
  SBAR(); qkt(pB0, pB1, (bf16*)((char*)K_lds + SHM_K), qr, r32, hi);
  finishSM(pA0, pA1, alA, l_reg, pa0, pa1, pa2, pa3); SBAR();
  pv_d0(o, vb0, pa0, pa1, pa2, pa3); partialSM(pB0, pB1, m_reg, mnB, alB);
  __syncthreads(); RESC(alB);
  finishSM(pB0, pB1, alB, l_reg, pa0, pa1, pa2, pa3); SBAR();
  pv_d0(o, vb0 + (int)SHM_V, pa0, pa1, pa2, pa3);
  if (hi == 0) li_l[r32] = l_reg; asm volatile("s_waitcnt lgkmcnt(0)" ::: "memory");
  float rli[16];
#pragma unroll
  for (int r = 0; r < 16; ++r) rli[r] = __builtin_amdgcn_rcpf(li_l[crow(r, hi)]);
  float* Ow = Ob + (long)(wid * QBLK) * LDO;
#pragma unroll
  for (int r = 0; r < 16; ++r) { int orow = crow(r, hi);
    for (int d0 = 0; d0 < 4; ++d0) Ow[(long)orow * LDO + d0 * 32 + r32] = o[d0][r] * rli[r]; }
#undef SLOAD
#undef SWRITE
#undef SWAIT
#undef RESC
}
}

namespace mk {
#define LAS __attribute__((address_space(3)))
typedef unsigned short bf16_t;
typedef short bf16x8 __attribute__((ext_vector_type(8)));
typedef float f32x4 __attribute__((ext_vector_type(4)));
typedef float f32x2 __attribute__((ext_vector_type(2)));
typedef float f32x16 __attribute__((ext_vector_type(16)));
typedef unsigned u32x4 __attribute__((ext_vector_type(4)));
typedef unsigned u32x2 __attribute__((ext_vector_type(2)));
constexpr int M = 16384, DM = 1024, T = 8192, FF = 2816, NIN = 3584, NTH = 512, NWAVES = 8;
constexpr int LDS_BYTES = 131072;
constexpr float EPS = 1e-6f, LOG2E = 1.4426950408889634f, LN2 = 0.6931471805599453f;
constexpr size_t WS_SSA = 0, WS_SSB = (size_t)1 << 20, WS_DC = (size_t)2 << 20, WS_ASS = (size_t)3 << 20, WS_W = (size_t)4 << 20;
constexpr size_t SZ_W1T = (size_t)2 * FF * DM * 2, SZ_W2T = (size_t)DM * FF * 2, SZ_WIN = (size_t)NIN * DM * 2, SZ_WO = (size_t)DM * DM * 2;
constexpr size_t WS_W1A = WS_W, WS_W2A = WS_W1A + SZ_W1T, WS_WIN = WS_W2A + SZ_W2T, WS_WO = WS_WIN + SZ_WIN, WS_W1B = WS_WO + SZ_WO, WS_W2B = WS_W1B + SZ_W1T;
constexpr size_t WS_X = WS_W2B + SZ_W2T;
constexpr size_t WS_B = WS_X + (size_t)M * DM * 2;
constexpr size_t WS_PR = WS_B + (size_t)M * 1024 * 2;
constexpr size_t WS_C = WS_B + (size_t)M * NIN * 2;
constexpr size_t WS_END = WS_C + (size_t)2048 * 16384 * 2;

__device__ __forceinline__ float bf_lo(unsigned u) { return __uint_as_float(u << 16); }
__device__ __forceinline__ float bf_hi(unsigned u) { return __uint_as_float(u & 0xffff0000u); }
__device__ __forceinline__ unsigned pk(float lo, float hi) { return pg8::cvt_pk_bf16(lo, hi); }
__device__ __forceinline__ float wave_sum(float v) {
#pragma unroll
    for (int o = 1; o < 64; o <<= 1) v += __shfl_xor(v, o);
    return v;
}
__device__ __forceinline__ float fexp(float x) { return __builtin_amdgcn_exp2f(x * LOG2E); }
__device__ __forceinline__ int crow(int r, int hi) { return (r & 3) + 8 * (r >> 2) + 4 * hi; }
#define LDSW() asm volatile("s_waitcnt lgkmcnt(0)" ::: "memory")

struct Args { const float* in[16]; float* out; unsigned char* ws; int lo, hi; };

__device__ __forceinline__ void tr_item(const float* W, int K, int N, bf16_t* WT, const float* gain, bool swiglu, LAS float* scr, int item, int lane) {
    const int nblk = N / 32, kb = item / nblk, nb = item % nblk, k0 = 64 * kb, n0 = 32 * nb;
    float wv[32];
#pragma unroll
    for (int i = 0; i < 32; ++i) wv[i] = W[(size_t)(k0 + 2 * i + (lane >> 5)) * N + n0 + (lane & 31)];
#pragma unroll
    for (int i = 0; i < 32; ++i) { const int kk = 2 * i + (lane >> 5); float v = wv[i]; if (gain) v *= gain[k0 + kk]; scr[kk * 33 + (lane & 31)] = v; }
    LDSW();
    int dst = n0;
    if (swiglu) { const int half = N / 2; dst = (n0 < half) ? (n0 / 128) * 256 + (n0 % 128) : ((n0 - half) / 128) * 256 + 128 + ((n0 - half) % 128); }
    const int c = lane & 7;
#pragma unroll
    for (int j = 0; j < 4; ++j) { const int n = (lane >> 3) + 8 * j; const LAS float* s = scr + (8 * c) * 33 + n;
        u32x4 o; o.x = pk(s[0 * 33], s[1 * 33]); o.y = pk(s[2 * 33], s[3 * 33]); o.z = pk(s[4 * 33], s[5 * 33]); o.w = pk(s[6 * 33], s[7 * 33]);
        *(u32x4*)(WT + (size_t)(dst + n) * K + k0 + 8 * c) = o; }
    LDSW();
}

__device__ __forceinline__ void rec_gates(const bf16_t* zp  , float lb0, float lb1, float (&g)[8][2], float (&kk)[8][2]) {
#pragma unroll
    for (int i = 0; i < 8; ++i) { const unsigned z = *(const unsigned*)(zp + (size_t)i * 2560);
        const float z0 = bf_lo(z), z1 = bf_hi(z);
        const float s0 = __builtin_amdgcn_rcpf(1.0f + fexp(-z0)), s1 = __builtin_amdgcn_rcpf(1.0f + fexp(-z1));
        const float f0 = lb0 + (1.0f - lb0) * s0, f1 = lb1 + (1.0f - lb1) * s1;
        g[i][0] = __builtin_amdgcn_logf(f0) * LN2; g[i][1] = __builtin_amdgcn_logf(f1) * LN2;
        kk[i][0] = (1.0f - lb0) * (1.0f - s0); kk[i][1] = (1.0f - lb1) * (1.0f - s1); }
}
__device__ __forceinline__ void seg_scan(float (&g)[8][2], int dir, float& t0, float& t1) {
    if (dir == 0) {
#pragma unroll
        for (int i = 1; i < 8; ++i) { g[i][0] += g[i - 1][0]; g[i][1] += g[i - 1][1]; }
        t0 = g[7][0]; t1 = g[7][1];
    } else {
#pragma unroll
        for (int i = 6; i >= 0; --i) { g[i][0] += g[i + 1][0]; g[i][1] += g[i + 1][1]; }
        t0 = g[0][0]; t1 = g[0][1];
    }
}
constexpr int R_VT = 0, R_KT = 18432, R_TS = 55296, R_QT = 63488, R_KT2 = 80896, R_QH = 98304, R_PB = 115712, R_OS = 63488;

__device__ __forceinline__ void lb_pair(const float* lbl, int dir, int ch, float& lb0, float& lb1) {
    const float a0 = lbl[dir * 1024 + ch], a1 = lbl[dir * 1024 + 512 + ch], b0 = lbl[dir * 1024 + ch + 1], b1 = lbl[dir * 1024 + 512 + ch + 1];
    lb0 = 1.0f / (1.0f + expf(a1 - a0)); lb1 = 1.0f / (1.0f + expf(b1 - b0));
}

__device__ __forceinline__ void rec_local(LAS unsigned char* lds, const bf16_t* PR, const float* lbl, bf16_t* LST, float* DC, int item, int tid) {
    const int b = item >> 9, h = (item >> 7) & 3, c = item & 127;
    const int lane = tid & 63, seg = tid >> 6, d0 = 2 * lane, r32 = lane & 31, hi = lane >> 5;
    const size_t row0 = (size_t)b * T + 64 * c + 8 * seg;
    {
        unsigned vv[8];
#pragma unroll
        for (int i = 0; i < 8; ++i) vv[i] = *(const unsigned*)(PR + (row0 + i) * 2560 + 1536 + h * 128 + d0);
        u32x4 lo, hi4;
        lo.x = (vv[0] & 0xffffu) | (vv[1] << 16); lo.y = (vv[2] & 0xffffu) | (vv[3] << 16); lo.z = (vv[4] & 0xffffu) | (vv[5] << 16); lo.w = (vv[6] & 0xffffu) | (vv[7] << 16);
        hi4.x = (vv[0] >> 16) | (vv[1] & 0xffff0000u); hi4.y = (vv[2] >> 16) | (vv[3] & 0xffff0000u); hi4.z = (vv[4] >> 16) | (vv[5] & 0xffff0000u); hi4.w = (vv[6] >> 16) | (vv[7] & 0xffff0000u);
        *(LAS u32x4*)(lds + R_VT + (d0 * 72 + 8 * seg) * 2) = lo; *(LAS u32x4*)(lds + R_VT + ((d0 + 1) * 72 + 8 * seg) * 2) = hi4;
    }
    float g[2][8][2], kk[2][8][2];
#pragma unroll
    for (int dir = 0; dir < 2; ++dir) {
        float lb0, lb1; lb_pair(lbl, dir, h * 128 + d0, lb0, lb1);
        rec_gates(PR + row0 * 2560 + 512 + dir * 512 + h * 128 + d0, lb0, lb1, g[dir], kk[dir]);
        float t0, t1; seg_scan(g[dir], dir, t0, t1);
        *(LAS f32x2*)(lds + R_TS + ((dir * 8 + seg) * 128 + d0) * 4) = (f32x2){t0, t1};
    }
    LDSW(); __syncthreads();
#pragma unroll
    for (int dir = 0; dir < 2; ++dir) {
        float off0 = 0.f, off1 = 0.f, tot0 = 0.f, tot1 = 0.f;
#pragma unroll
        for (int s = 0; s < 8; ++s) { const f32x2 t = *(const LAS f32x2*)(lds + R_TS + ((dir * 8 + s) * 128 + d0) * 4); tot0 += t.x; tot1 += t.y;
            const bool before = dir == 0 ? (s < seg) : (s > seg); if (before) { off0 += t.x; off1 += t.y; } }
        float k0[8], k1[8];
#pragma unroll
        for (int i = 0; i < 8; ++i) { k0[i] = kk[dir][i][0] * fexp(tot0 - (g[dir][i][0] + off0)); k1[i] = kk[dir][i][1] * fexp(tot1 - (g[dir][i][1] + off1)); }
#if defined(RL_TEST) && RL_TEST == 1
#pragma unroll
        for (int i = 0; i < 8; ++i) { k0[i] = 1.0f; k1[i] = 1.0f; }
#endif
        u32x4 w0, w1; w0.x = pk(k0[0], k0[1]); w0.y = pk(k0[2], k0[3]); w0.z = pk(k0[4], k0[5]); w0.w = pk(k0[6], k0[7]);
        w1.x = pk(k1[0], k1[1]); w1.y = pk(k1[2], k1[3]); w1.z = pk(k1[4], k1[5]); w1.w = pk(k1[6], k1[7]);
        *(LAS u32x4*)(lds + R_KT + dir * 18432 + (d0 * 72 + 8 * seg) * 2) = w0; *(LAS u32x4*)(lds + R_KT + dir * 18432 + ((d0 + 1) * 72 + 8 * seg) * 2) = w1;
        if (seg == 0) { const int chain = (b * 4 + h) * 2 + dir; *(f32x2*)(DC + ((size_t)(chain * 128 + c)) * 128 + d0) = (f32x2){fexp(tot0), fexp(tot1)}; }
    }
    LDSW(); __syncthreads();
    {
        const int dir = seg >> 2, mt = seg & 3;
        f32x16 acc[4];
#pragma unroll
        for (int n = 0; n < 4; ++n) acc[n] = (f32x16){};
#pragma unroll
        for (int ks = 0; ks < 4; ++ks) { const bf16x8 a = *(const LAS bf16x8*)(lds + R_VT + ((32 * mt + r32) * 72 + 16 * ks + 8 * hi) * 2);
#pragma unroll
            for (int n = 0; n < 4; ++n) { const bf16x8 bb = *(const LAS bf16x8*)(lds + R_KT + dir * 18432 + ((32 * n + r32) * 72 + 16 * ks + 8 * hi) * 2);
                acc[n] = __builtin_amdgcn_mfma_f32_32x32x16_bf16(a, bb, acc[n], 0, 0, 0); } }
        const int chain = (b * 4 + h) * 2 + dir; bf16_t* L = LST + ((size_t)(chain * 128 + c) << 14);
#pragma unroll
        for (int n = 0; n < 4; ++n)
#pragma unroll
            for (int r = 0; r < 16; ++r) { const int dv = 32 * mt + crow(r, hi), dk = 32 * n + r32; L[dv * 128 + dk] = (bf16_t)(pk(acc[n][r], 0.f) & 0xffffu); }
    }
    __syncthreads();
}

__device__ __forceinline__ void gates_from(const unsigned (&z)[8], float lb0, float lb1, float (&g)[8][2], float (&kk)[8][2]) {
#pragma unroll
    for (int i = 0; i < 8; ++i) { const float z0 = bf_lo(z[i]), z1 = bf_hi(z[i]);
        const float s0 = __builtin_amdgcn_rcpf(1.0f + fexp(-z0)), s1 = __builtin_amdgcn_rcpf(1.0f + fexp(-z1));
        const float f0 = lb0 + (1.0f - lb0) * s0, f1 = lb1 + (1.0f - lb1) * s1;
        g[i][0] = __builtin_amdgcn_logf(f0) * LN2; g[i][1] = __builtin_amdgcn_logf(f1) * LN2;
        kk[i][0] = (1.0f - lb0) * (1.0f - s0); kk[i][1] = (1.0f - lb1) * (1.0f - s1); }
}
__device__ __forceinline__ void rec_out(LAS unsigned char* lds, const bf16_t* PR, const float* lbl, const bf16_t* SP, const float* AO, const float* ASS,
                                        const float* attn_gain, const float* rec_gain, bf16_t* MIX, int item, int h, float& ra, int tid) {
    const int b = item >> 7, c = item & 127;
    const int lane = tid & 63, seg = tid >> 6, d0 = 2 * lane, r32 = lane & 31, hi = lane >> 5;
    const size_t rowc = (size_t)b * T + 64 * c, row0 = rowc + 8 * seg;
    const int mt = seg >> 2, nt = seg & 3;
    const int bt = (seg >> 1) & 1, bs = seg & 1;
    const int erow = tid >> 3, sg = tid & 7; const size_t grow = rowc + erow;
    unsigned vv[8], qq[8], zz[2][8];
#pragma unroll
    for (int i = 0; i < 8; ++i) { const bf16_t* rp = PR + (row0 + i) * 2560 + h * 128 + d0;
        qq[i] = *(const unsigned*)rp; zz[0][i] = *(const unsigned*)(rp + 512); zz[1][i] = *(const unsigned*)(rp + 1024); vv[i] = *(const unsigned*)(rp + 1536); }
    if (h == 0) { float sa = 0.f;
#pragma unroll 4
        for (int j = 0; j < 16; ++j) { const f32x4 t4 = *(const f32x4*)(AO + grow * 512 + 64 * sg + 4 * j); sa += (t4[0] * t4[0] + t4[1] * t4[1]) + (t4[2] * t4[2] + t4[3] * t4[3]); }
        sa += __shfl_xor(sa, 1); sa += __shfl_xor(sa, 2); sa += __shfl_xor(sa, 4);
        ra = 1.0f / sqrtf(sa * (1.0f / 512.0f) + EPS); }
    {
        u32x4 lo, hi4;
        lo.x = (vv[0] & 0xffffu) | (vv[1] << 16); lo.y = (vv[2] & 0xffffu) | (vv[3] << 16); lo.z = (vv[4] & 0xffffu) | (vv[5] << 16); lo.w = (vv[6] & 0xffffu) | (vv[7] << 16);
        hi4.x = (vv[0] >> 16) | (vv[1] & 0xffff0000u); hi4.y = (vv[2] >> 16) | (vv[3] & 0xffff0000u); hi4.z = (vv[4] >> 16) | (vv[5] & 0xffff0000u); hi4.w = (vv[6] >> 16) | (vv[7] & 0xffff0000u);
        *(LAS u32x4*)(lds + R_VT + (d0 * 72 + 8 * seg) * 2) = lo; *(LAS u32x4*)(lds + R_VT + ((d0 + 1) * 72 + 8 * seg) * 2) = hi4;
    }
    f32x16 oacc = (f32x16){}, pacc = (f32x16){};
#pragma unroll
    for (int dir = 0; dir < 2; ++dir) {
        asm volatile("" ::: "memory");
        bf16x8 sb[8];
        { const int chain = (b * 4 + h) * 2 + dir; const bf16_t* S = SP + ((size_t)(chain * 128 + c) << 14) + (size_t)(32 * nt + r32) * 128 + 8 * hi;
#pragma unroll
            for (int ks = 0; ks < 8; ++ks) sb[ks] = *(const bf16x8*)(S + 16 * ks); }
        float g[8][2], kk[8][2];
        float lb0, lb1; lb_pair(lbl, dir, h * 128 + d0, lb0, lb1);
        gates_from(zz[dir], lb0, lb1, g, kk);
        float t0, t1; seg_scan(g, dir, t0, t1);
        *(LAS f32x2*)(lds + R_TS + (seg * 128 + d0) * 4) = (f32x2){t0, t1};
        LDSW(); __syncthreads();
        float off0 = 0.f, off1 = 0.f, ref0 = 0.f, ref1 = 0.f;
#pragma unroll
        for (int s = 0; s < 8; ++s) { const f32x2 t = *(const LAS f32x2*)(lds + R_TS + (s * 128 + d0) * 4);
            const bool before = dir == 0 ? (s < seg) : (s > seg); if (before) { off0 += t.x; off1 += t.y; }
            const bool inref = dir == 0 ? (s < 4) : (s >= 4); if (inref) { ref0 += t.x; ref1 += t.y; } }
#pragma unroll
        for (int i = 0; i < 8; ++i) {
            const float q0 = bf_lo(qq[i]), q1 = bf_hi(qq[i]);
            const float b0 = g[i][0] + off0, b1 = g[i][1] + off1;
            const float eq0 = fexp(b0 - ref0), eq1 = fexp(b1 - ref1), ek0 = fexp(ref0 - b0), ek1 = fexp(ref1 - b1), eh0 = fexp(b0), eh1 = fexp(b1);
            const int ro = ((8 * seg + i) * 136 + d0) * 2;
            *(LAS unsigned*)(lds + R_QT + ro) = pk(q0 * eq0, q1 * eq1);
            *(LAS unsigned*)(lds + R_KT2 + ro) = pk(kk[i][0] * ek0, kk[i][1] * ek1);
            *(LAS unsigned*)(lds + R_QH + ro) = pk(q0 * eh0, q1 * eh1);
        }
        LDSW(); __syncthreads();
        if (seg < 4 && !((dir == 0 && bt == 0 && bs == 1) || (dir == 1 && bt == 1 && bs == 0))) {
            f32x16 sc = (f32x16){};
#pragma unroll
            for (int ks = 0; ks < 8; ++ks) {
                const bf16x8 a = *(const LAS bf16x8*)(lds + R_QT + ((32 * bt + r32) * 136 + 16 * ks + 8 * hi) * 2);
                const bf16x8 bb = *(const LAS bf16x8*)(lds + R_KT2 + ((32 * bs + r32) * 136 + 16 * ks + 8 * hi) * 2);
                sc = __builtin_amdgcn_mfma_f32_32x32x16_bf16(a, bb, sc, 0, 0, 0); }
#pragma unroll
            for (int r = 0; r < 16; ++r) { const int t = 32 * bt + crow(r, hi), s = 32 * bs + r32; const bool keep = dir == 0 ? (s <= t) : (s >= t); pacc[r] += keep ? sc[r] : 0.f; }
        }
#pragma unroll
        for (int ks = 0; ks < 8; ++ks) { const bf16x8 a = *(const LAS bf16x8*)(lds + R_QH + ((32 * mt + r32) * 136 + 16 * ks + 8 * hi) * 2);
            oacc = __builtin_amdgcn_mfma_f32_32x32x16_bf16(a, sb[ks], oacc, 0, 0, 0); }
        LDSW(); __syncthreads();
    }
    asm volatile("" ::: "memory");
    const u32x4 gz0 = *(const u32x4*)(PR + grow * 2560 + 2048 + h * 128 + 16 * sg), gz1 = *(const u32x4*)(PR + grow * 2560 + 2048 + h * 128 + 16 * sg + 8);
    f32x4 a4[4];
#pragma unroll
    for (int j = 0; j < 4; ++j) a4[j] = *(const f32x4*)(AO + grow * 512 + h * 128 + 16 * sg + 4 * j);
    if (seg < 4) {
#pragma unroll
        for (int r = 0; r < 16; ++r) { const int t = 32 * bt + crow(r, hi), s = 32 * bs + r32; *(LAS bf16_t*)(lds + R_PB + (t * 72 + s) * 2) = (bf16_t)(pk(pacc[r], 0.f) & 0xffffu); }
    }
    LDSW(); __syncthreads();
#pragma unroll
    for (int ks = 0; ks < 4; ++ks) { const bf16x8 a = *(const LAS bf16x8*)(lds + R_PB + ((32 * mt + r32) * 72 + 16 * ks + 8 * hi) * 2);
        const bf16x8 bb = *(const LAS bf16x8*)(lds + R_VT + ((32 * nt + r32) * 72 + 16 * ks + 8 * hi) * 2);
        oacc = __builtin_amdgcn_mfma_f32_32x32x16_bf16(a, bb, oacc, 0, 0, 0); }
#pragma unroll
    for (int r = 0; r < 16; ++r) *(LAS float*)(lds + R_OS + ((32 * mt + crow(r, hi)) * 132 + 32 * nt + r32) * 4) = oacc[r];
    LDSW(); __syncthreads();
    {
        f32x4 o4[4]; float ss = 0.f;
#pragma unroll
        for (int j = 0; j < 4; ++j) { o4[j] = *(const LAS f32x4*)(lds + R_OS + (erow * 132 + 16 * sg + 4 * j) * 4); ss += (o4[j][0] * o4[j][0] + o4[j][1] * o4[j][1]) + (o4[j][2] * o4[j][2] + o4[j][3] * o4[j][3]); }
        ss += __shfl_xor(ss, 1); ss += __shfl_xor(ss, 2); ss += __shfl_xor(ss, 4);
        const float rstd = 1.0f / sqrtf(ss * (1.0f / 128.0f) + EPS);
        const unsigned gz[8] = {gz0.x, gz0.y, gz0.z, gz0.w, gz1.x, gz1.y, gz1.z, gz1.w};
        float res[16];
#pragma unroll
        for (int e = 0; e < 16; ++e) { const float gt = (e & 1) ? bf_hi(gz[e >> 1]) : bf_lo(gz[e >> 1]); res[e] = o4[e >> 2][e & 3] * rstd * rec_gain[16 * sg + e] * pg8::silu_f(gt); }
        u32x4 w0, w1; w0.x = pk(res[0], res[1]); w0.y = pk(res[2], res[3]); w0.z = pk(res[4], res[5]); w0.w = pk(res[6], res[7]);
        w1.x = pk(res[8], res[9]); w1.y = pk(res[10], res[11]); w1.z = pk(res[12], res[13]); w1.w = pk(res[14], res[15]);
        *(u32x4*)(MIX + grow * 1024 + 512 + h * 128 + 16 * sg) = w0; *(u32x4*)(MIX + grow * 1024 + 512 + h * 128 + 16 * sg + 8) = w1;
        float av[16];
#pragma unroll
        for (int j = 0; j < 4; ++j) { const f32x4 g4 = *(const f32x4*)(attn_gain + h * 128 + 16 * sg + 4 * j);
            av[4 * j + 0] = a4[j][0] * ra * g4[0]; av[4 * j + 1] = a4[j][1] * ra * g4[1]; av[4 * j + 2] = a4[j][2] * ra * g4[2]; av[4 * j + 3] = a4[j][3] * ra * g4[3]; }
        w0.x = pk(av[0], av[1]); w0.y = pk(av[2], av[3]); w0.z = pk(av[4], av[5]); w0.w = pk(av[6], av[7]);
        w1.x = pk(av[8], av[9]); w1.y = pk(av[10], av[11]); w1.z = pk(av[12], av[13]); w1.w = pk(av[14], av[15]);
        *(u32x4*)(MIX + grow * 1024 + h * 128 + 16 * sg) = w0; *(u32x4*)(MIX + grow * 1024 + h * 128 + 16 * sg + 8) = w1;
    }
    __syncthreads();
}

__device__ __forceinline__ void qk_norm_rope(bf16_t* PA, const float* qg, const float* kg, int gw, int ngw, int lane) {
    const int a = lane & 15, half = a >> 3, j0 = (a & 3) * 8; const bool isx2 = (a & 4) != 0;
    float invf[8];
#pragma unroll
    for (int e = 0; e < 8; ++e) invf[e] = __builtin_amdgcn_exp2f(-(float)(j0 + e) * 0.41524101186092029f) * 0.15915494309189535f;
    for (int gi = gw; gi < M * 6 / 4; gi += 2 * ngw) {
        bf16_t* pp[2]; u32x4 rawv[2]; int rows[2], hvs[2];
#pragma unroll
        for (int q2 = 0; q2 < 2; ++q2) { const int g2 = gi + q2 * ngw; const int vid = g2 * 4 + (lane >> 4); rows[q2] = vid / 6; hvs[q2] = vid - rows[q2] * 6;
            pp[q2] = PA + (size_t)rows[q2] * 1024 + hvs[q2] * 128 + 8 * a; rawv[q2] = (g2 < M * 6 / 4) ? *(const u32x4*)pp[q2] : (u32x4){0u, 0u, 0u, 0u}; }
#pragma unroll
        for (int q2 = 0; q2 < 2; ++q2) {
            const int row = rows[q2], hv = hvs[q2]; const u32x4 raw = rawv[q2]; const unsigned rw[4] = {raw.x, raw.y, raw.z, raw.w};
            float x[8]; float ss = 0.f;
#pragma unroll
            for (int e = 0; e < 4; ++e) { x[2 * e] = bf_lo(rw[e]); x[2 * e + 1] = bf_hi(rw[e]); ss += x[2 * e] * x[2 * e] + x[2 * e + 1] * x[2 * e + 1]; }
            ss += __shfl_xor(ss, 1); ss += __shfl_xor(ss, 2); ss += __shfl_xor(ss, 4); ss += __shfl_xor(ss, 8);
            const float rstd = 1.0f / sqrtf(ss * (1.0f / 128.0f) + EPS);
            const float* gn = (hv < 4 ? qg : kg) + 8 * a;
            float y[8], yp[8];
#pragma unroll
            for (int e = 0; e < 8; ++e) y[e] = x[e] * rstd * gn[e];
#pragma unroll
            for (int e = 0; e < 8; ++e) yp[e] = __shfl_xor(y[e], 4);
            const int t = row & (T - 1); const float id = (float)(half ? (t & 63) : (t >> 6));
            float o[8];
#pragma unroll
            for (int e = 0; e < 8; ++e) { const float rev = id * invf[e], fr = rev - floorf(rev); const float cs = __builtin_amdgcn_cosf(fr), sn = __builtin_amdgcn_sinf(fr);
                o[e] = isx2 ? (y[e] * cs + yp[e] * sn) : (y[e] * cs - yp[e] * sn); }
            u32x4 w; w.x = pk(o[0], o[1]); w.y = pk(o[2], o[3]); w.z = pk(o[4], o[5]); w.w = pk(o[6], o[7]);
            if (gi + q2 * ngw < M * 6 / 4) *(u32x4*)pp[q2] = w;
        }
    }
}

__global__ void __launch_bounds__(NTH, 2) hybrid_fwd(Args args) {
    extern __shared__ __attribute__((aligned(16))) unsigned char lds_raw[];
    LAS unsigned char* lds = (LAS unsigned char*)lds_raw;
    const int tid = threadIdx.x, lane = tid & 63, wave = __builtin_amdgcn_readfirstlane(tid >> 6);
    const int G = gridDim.x, gw = blockIdx.x * NWAVES + wave, NGW = G * NWAVES;
    unsigned char* ws = args.ws;
    const float* x = args.in[0];
    float* out = args.out;
    float* SSA = (float*)(ws + WS_SSA); float* SSB = (float*)(ws + WS_SSB); float* DC = (float*)(ws + WS_DC); float* ASS = (float*)(ws + WS_ASS);
    bf16_t* W1A = (bf16_t*)(ws + WS_W1A); bf16_t* W2A = (bf16_t*)(ws + WS_W2A); bf16_t* WIN = (bf16_t*)(ws + WS_WIN); bf16_t* WO = (bf16_t*)(ws + WS_WO);
    bf16_t* W1B = (bf16_t*)(ws + WS_W1B); bf16_t* W2B = (bf16_t*)(ws + WS_W2B);
    bf16_t* XB = (bf16_t*)(ws + WS_X); float* AO = (float*)(ws + WS_X); bf16_t* X2B = (bf16_t*)(ws + WS_X);
    bf16_t* H = (bf16_t*)(ws + WS_B); bf16_t* PA = (bf16_t*)(ws + WS_B); bf16_t* PR = (bf16_t*)(ws + WS_PR); bf16_t* MIX = (bf16_t*)(ws + WS_B);
    bf16_t* LST = (bf16_t*)(ws + WS_C);
    bf16_t* X1S = (bf16_t*)out;
    const int lo = args.lo, hi = args.hi;
#ifdef PH_ONLY
#define IN(k) ((k) == PH_ONLY && lo <= (k) && (k) < hi)
#else
#define IN(k) (lo <= (k) && (k) < hi)
#endif
#ifdef TS_LO
    unsigned long long ts_t0 = 0, ts_t1 = 0;
#define TS_A(k) do { if ((k) == TS_LO) ts_t0 = __builtin_amdgcn_s_memrealtime(); } while (0)
#define TS_B(k) do { if ((k) == TS_HI) ts_t1 = __builtin_amdgcn_s_memrealtime(); } while (0)
#else
#define TS_A(k) do {} while (0)
#define TS_B(k) do {} while (0)
#endif
#define SEAM(k) do { if (IN(k) && IN((k) + 1)) { cg::this_grid().sync(); } TS_B(k); TS_A((k) + 1); } while (0)

    TS_A(0);
    if (IN(0)) {
        LAS float* scr = (LAS float*)(lds + wave * 8448);
        constexpr int I1 = (DM / 64) * (2 * FF / 32), I2 = (FF / 64) * (DM / 32), I3 = (DM / 64) * (NIN / 32), I4 = (DM / 64) * (DM / 32);
        constexpr int NITEMS = 2 * I1 + 2 * I2 + I3 + I4;
        for (int it = gw; it < NITEMS; it += NGW) {
            int r = it;
            if (r < I1) { tr_item(args.in[2], DM, 2 * FF, W1A, args.in[1], true, scr, r, lane); continue; } r -= I1;
            if (r < I2) { tr_item(args.in[3], FF, DM, W2A, nullptr, false, scr, r, lane); continue; } r -= I2;
            if (r < I3) { tr_item(args.in[5], DM, NIN, WIN, args.in[4], false, scr, r, lane); continue; } r -= I3;
            if (r < I4) { tr_item(args.in[11], DM, DM, WO, nullptr, false, scr, r, lane); continue; } r -= I4;
            if (r < I1) { tr_item(args.in[13], DM, 2 * FF, W1B, args.in[12], true, scr, r, lane); continue; } r -= I1;
            tr_item(args.in[14], FF, DM, W2B, nullptr, false, scr, r, lane);
        }
        for (int m0 = gw; m0 < M; m0 += 2 * NGW) {
            f32x4 v[2][4]; float sq[2];
#pragma unroll
            for (int q2 = 0; q2 < 2; ++q2) { const int m = m0 + q2 * NGW < M ? m0 + q2 * NGW : m0; const f32x4* xr = (const f32x4*)(x + (size_t)m * DM) + lane;
#pragma unroll
                for (int j = 0; j < 4; ++j) v[q2][j] = xr[64 * j]; }
#pragma unroll
            for (int q2 = 0; q2 < 2; ++q2) { float s = 0.f;
#pragma unroll
                for (int j = 0; j < 4; ++j) s += (v[q2][j][0] * v[q2][j][0] + v[q2][j][1] * v[q2][j][1]) + (v[q2][j][2] * v[q2][j][2] + v[q2][j][3] * v[q2][j][3]);
                sq[q2] = wave_sum(s); }
#pragma unroll
            for (int q2 = 0; q2 < 2; ++q2) { const int m = m0 + q2 * NGW; if (m < M) { u32x2* o8 = (u32x2*)(XB + (size_t)m * DM) + lane;
#pragma unroll
                for (int j = 0; j < 4; ++j) o8[64 * j] = (u32x2){pk(v[q2][j][0], v[q2][j][1]), pk(v[q2][j][2], v[q2][j][3])};
                if (lane < 16) SSA[(size_t)m * 16 + lane] = lane == 0 ? sq[q2] : 0.f; } }
        }
        __syncthreads();
    }
    SEAM(0);
    if (IN(1)) { pg8::Gemm g{XB, W1A, M, 2 * FF, DM}; pg8::StaticOrder S; S.init(M, 2 * FF, G, (int)blockIdx.x); pg8::EpiSwiGLU E{H, FF, SSA};
        pg8::gemm_phase<pg8::EpiSwiGLU, pg8::StaticOrder, true, true>(lds, g, S, E); }
    SEAM(1);
    if (IN(2)) { pg8::Gemm g{H, W2A, M, DM, FF}; pg8::StaticOrder S; S.init(M, DM, G, (int)blockIdx.x); pg8::EpiResid<false, false> E{x, X1S, SSB, 0.5f};
        pg8::gemm_phase<pg8::EpiResid<false, false>, pg8::StaticOrder, true, true>(lds, g, S, E); }
    SEAM(2);
    if (IN(3)) { pg8::Gemm g{X1S, WIN, M, NIN, DM}; pg8::StaticOrder S; S.init(M, NIN, G, (int)blockIdx.x); pg8::EpiProj E{PA, PR, SSB};
        pg8::gemm_phase<pg8::EpiProj, pg8::StaticOrder, true, true>(lds, g, S, E); }
    SEAM(3);
    if (IN(4)) {
        qk_norm_rope(PA, args.in[6], args.in[7], gw, NGW, lane);
        for (int it = blockIdx.x; it < 1024; it += G) rec_local(lds, PR, args.in[9], LST, DC, it, tid);
    }
    SEAM(4);
    if (IN(5)) {
#ifndef X_NOSCAN
        for (int p = blockIdx.x * NTH + tid; p < 16 * 8192; p += G * NTH) {
            const int chain = p >> 13, pair = p & 8191, dk0 = (pair & 63) * 2, dir = chain & 1;
            float s0 = 0.f, s1 = 0.f;
#pragma unroll 16
            for (int st = 0; st < 128; ++st) { const int c = dir ? 127 - st : st;
                unsigned* ptr = (unsigned*)(LST + ((size_t)(chain * 128 + c) << 14)) + pair;
                const unsigned l = *ptr; const f32x2 dc = *(const f32x2*)(DC + (size_t)(chain * 128 + c) * 128 + dk0);
                *ptr = pk(s0, s1);
                s0 = dc.x * s0 + bf_lo(l); s1 = dc.y * s1 + bf_hi(l); }
        }
#endif
#ifdef X_NOLOOP
        { const int u = blockIdx.x;
#else
        for (int u = blockIdx.x; u < 256; u += G) {
#endif
            const int xcd = u & 7, j = u >> 3, pair = xcd >> 1, b = pair >> 1, kvh = pair & 1, h = 2 * kvh + (xcd & 1);
            const size_t r0 = (size_t)b * T + 256 * j;
            att::attn_dense_body<att::bf16>((const att::bf16*)(PA + r0 * 1024 + h * 128), (const att::bf16*)(PA + (size_t)b * T * 1024 + 512 + kvh * 128),
                                            (const att::bf16*)(PA + (size_t)b * T * 1024 + 768 + kvh * 128), AO + r0 * 512 + h * 128, T, (char*)lds_raw);
            __syncthreads();
        }
    }
    SEAM(5);
    if (IN(6)) { for (int it = blockIdx.x; it < 256; it += G) { float ra = 0.f;
#pragma unroll 1
        for (int h = 0; h < 4; ++h) rec_out(lds, PR, args.in[9], LST, AO, ASS, args.in[8], args.in[10], MIX, it, h, ra, tid); } }
    SEAM(6);
    if (IN(7)) { pg8::Gemm g{MIX, WO, M, DM, DM}; pg8::StaticOrder S; S.init(M, DM, G, (int)blockIdx.x); pg8::EpiResid<true, false> E{X1S, X2B, SSA, 1.0f};
        pg8::gemm_phase<pg8::EpiResid<true, false>, pg8::StaticOrder, true, true>(lds, g, S, E); }
    SEAM(7);
    if (IN(8)) { pg8::Gemm g{X2B, W1B, M, 2 * FF, DM}; pg8::StaticOrder S; S.init(M, 2 * FF, G, (int)blockIdx.x); pg8::EpiSwiGLU E{H, FF, SSA};
        pg8::gemm_phase<pg8::EpiSwiGLU, pg8::StaticOrder, true, true>(lds, g, S, E); }
    SEAM(8);
    if (IN(9)) { pg8::Gemm g{H, W2B, M, DM, FF}; pg8::StaticOrder S; S.init(M, DM, G, (int)blockIdx.x); pg8::EpiResid<true, true> E{X2B, out, nullptr, 0.5f};
        pg8::gemm_phase<pg8::EpiResid<true, true>, pg8::StaticOrder, true, true>(lds, g, S, E); }
    SEAM(9);
    if (IN(10)) {
        const float* fg = args.in[15];
        for (int m = gw; m < M; m += NGW) {
            f32x4* xr = (f32x4*)(out + (size_t)m * DM) + lane; f32x4 v[4]; float s = 0.f;
#pragma unroll
            for (int j = 0; j < 4; ++j) { v[j] = xr[64 * j]; s += (v[j][0] * v[j][0] + v[j][1] * v[j][1]) + (v[j][2] * v[j][2] + v[j][3] * v[j][3]); }
            const float rstd = 1.0f / sqrtf(wave_sum(s) * (1.0f / DM) + EPS);
#pragma unroll
            for (int j = 0; j < 4; ++j) { const f32x4 gn = *((const f32x4*)fg + lane + 64 * j); xr[64 * j] = v[j] * rstd * gn; }
        }
    }
#ifdef TS_LO
    TS_B(10);
    cg::this_grid().sync();
    if (blockIdx.x == 0) { const unsigned K = (unsigned)(ts_t1 - ts_t0); for (unsigned i = tid; i < K && i < 300000u; i += NTH) out[i] += 0.1f; }
#endif
#undef IN
#undef SEAM
}
}

#ifdef DBG
__global__ void dbg_dump_bf16(const unsigned short* src, float* out, size_t n) { for (size_t i = blockIdx.x * (size_t)blockDim.x + threadIdx.x; i < n; i += (size_t)gridDim.x * blockDim.x) out[i] = __uint_as_float((unsigned)src[i] << 16); }
__global__ void dbg_dump_f32(const float* src, float* out, size_t n) { for (size_t i = blockIdx.x * (size_t)blockDim.x + threadIdx.x; i < n; i += (size_t)gridDim.x * blockDim.x) out[i] = src[i]; }
#endif
extern "C" void kernel_launch(void* const* d_in, const int* in_sizes, int n_in, void* d_out, int out_size, void* d_ws, size_t ws_size, hipStream_t stream) {
    using namespace mk;
    static int grid = 0;
    if (grid == 0) {
        if (n_in != 16 || in_sizes[0] != M * DM || out_size != M * DM || ws_size < WS_END) {
            fprintf(stderr, "kernel_launch: built for 16 inputs, x/out of %d floats, >= %zu bytes of workspace; got n_in %d in0 %d out %d ws %zu\n", M * DM, (size_t)WS_END, n_in, n_in > 0 ? in_sizes[0] : -1, out_size, ws_size);
            grid = -1; return; }
        int dev = 0, cus = 0, per_cu = 0;
        hipGetDevice(&dev); hipDeviceGetAttribute(&cus, hipDeviceAttributeMultiprocessorCount, dev);
        if (hipFuncSetAttribute((const void*)hybrid_fwd, hipFuncAttributeMaxDynamicSharedMemorySize, LDS_BYTES) != hipSuccess) { fprintf(stderr, "kernel_launch: hipFuncSetAttribute failed\n"); grid = -1; return; }
        if (hipOccupancyMaxActiveBlocksPerMultiprocessor(&per_cu, (const void*)hybrid_fwd, NTH, LDS_BYTES) != hipSuccess || per_cu < 1) { fprintf(stderr, "kernel_launch: occupancy query says %d\n", per_cu); per_cu = 1; }
        (void)hipGetLastError();
        grid = cus * per_cu; if (grid > 256) grid = 256;
    }
    if (grid < 0) return;
    Args a{};
    for (int i = 0; i < 16; ++i) a.in[i] = (const float*)d_in[i];
    a.out = (float*)d_out; a.ws = (unsigned char*)d_ws;
#if MK_LAUNCHES == 1
    a.lo = 0; a.hi = 11;
    void* kargs[] = {&a};
    hipError_t e = hipLaunchCooperativeKernel((const void*)hybrid_fwd, dim3(grid), dim3(NTH), kargs, LDS_BYTES, stream);
    if (e != hipSuccess) fprintf(stderr, "kernel_launch: cooperative launch failed: %s (grid %d)\n", hipGetErrorString(e), grid);
#else
#ifdef DBG
    const int last = DBG == 7 ? 3 : DBG == 6 ? 6 : DBG == 5 ? 5 : DBG == 4 ? 4 : DBG == 3 ? 3 : DBG == 1 ? 1 : 2;
    for (int ph = 0; ph <= last; ++ph) { a.lo = ph; a.hi = ph + 1; hipLaunchKernelGGL(hybrid_fwd, dim3(grid), dim3(NTH), LDS_BYTES, stream, a); }
    const size_t n = (size_t)M * DM; unsigned char* w = (unsigned char*)d_ws;
    if (DBG == 6) hipLaunchKernelGGL(dbg_dump_bf16, dim3(1024), dim3(256), 0, stream, (const unsigned short*)(w + WS_B), (float*)d_out, n);
    if (DBG == 5) hipLaunchKernelGGL(dbg_dump_f32, dim3(1024), dim3(256), 0, stream, (const float*)(w + WS_X), (float*)d_out, n / 2);
    if (DBG == 4) hipLaunchKernelGGL(dbg_dump_bf16, dim3(1024), dim3(256), 0, stream, (const unsigned short*)(w + WS_C), (float*)d_out, n);
    if (DBG == 3) hipLaunchKernelGGL(dbg_dump_bf16, dim3(1024), dim3(256), 0, stream, (const unsigned short*)(w + WS_B), (float*)d_out, n);
    if (DBG == 7) hipLaunchKernelGGL(dbg_dump_bf16, dim3(1024), dim3(256), 0, stream, (const unsigned short*)(w + WS_PR), (float*)d_out, n);
    if (DBG == 1) hipLaunchKernelGGL(dbg_dump_bf16, dim3(1024), dim3(256), 0, stream, (const unsigned short*)(w + WS_B), (float*)d_out, n);
#else
    for (int ph = 0; ph < 11; ++ph) { a.lo = ph; a.hi = ph + 1; hipLaunchKernelGGL(hybrid_fwd, dim3(grid), dim3(NTH), LDS_BYTES, stream, a); }
#endif
#endif
}
```

```cpp
#include <hip/hip_runtime.h>
#include <hip/hip_bf16.h>
#include <hip/hip_cooperative_groups.h>
#include <cstdio>
#include <cstdint>
namespace cg = cooperative_groups;
#ifndef MK_LAUNCHES
#define MK_LAUNCHES 1
#endif
namespace pg8 {
#define PG8_LAS __attribute__((address_space(3)))
typedef unsigned short bf16_t;
typedef short bf16x8 __attribute__((ext_vector_type(8)));
typedef float f32x4 __attribute__((ext_vector_type(4)));
typedef unsigned u32x4 __attribute__((ext_vector_type(4)));
constexpr int BM = 256, BK = 64, HALF = 128, HTB = HALF * BK * 2  , STAGE_BYTES = 8 * HTB, NXCD = 8, WGM = 8;

__host__ __device__ __forceinline__ int lds_byte(int r, int c) { const int st = (r >> 4) * 2 + (c >> 5), rr = r & 15, cc = c & 31, ob = rr * 64 + cc * 2; return st * 1024 + (ob ^ (((ob >> 9) & 1) << 5)); }
__host__ __device__ __forceinline__ void stage_rc(int b, int& R, int& C) { const int st = b / 1024, sb = b % 1024, swz = sb ^ (((sb >> 9) & 1) << 5); R = (st >> 1) * 16 + swz / 64; C = (st & 1) * 32 + (swz % 64) / 2; }
__host__ __device__ __forceinline__ int perm32(int rho) { const int n = rho >> 4, i = rho & 15; return 8 * (i >> 2) + 4 * n + (i & 3); }

struct Unit { int pm, pn; };
struct Gemm { const bf16_t* A; const bf16_t* Bt; int M, N, K; };

struct StaticOrder {
    int nM, nN, nwg, G, c;
    __host__ __device__ void init(int M, int N, int G_, int c_) { nM = M / BM; nN = N / BM; nwg = nM * nN; G = G_; c = c_; }
    __host__ __device__ bool next(int i, Unit& u) const {
        const long L = (long)i * G + c; if (L >= nwg) return false;
        int wgid = (int)L; { const int q = nwg / NXCD, r = nwg % NXCD, xcd = wgid % NXCD, off = wgid / NXCD; wgid = (xcd < r ? xcd * (q + 1) : r * (q + 1) + (xcd - r) * q) + off; }
        const int nig = WGM * nN, gid = wgid / nig, fm = gid * WGM, gsz = (nM - fm) < WGM ? (nM - fm) : WGM;
        u.pm = fm + ((wgid % nig) % gsz); u.pn = (wgid % nig) / gsz; return true;
    }
    __device__ __forceinline__ void a_ready(const Unit&) const {}
    __device__ __forceinline__ void done(const Unit&) const {}
};

typedef __bf16 bf16x2_cv __attribute__((ext_vector_type(2)));
typedef float f32x2_cv __attribute__((ext_vector_type(2)));
__device__ __forceinline__ unsigned cvt_pk_bf16(float lo, float hi) { const bf16x2_cv v = __builtin_convertvector((f32x2_cv){lo, hi}, bf16x2_cv); return __builtin_bit_cast(unsigned, v); }
typedef float f32x2 __attribute__((ext_vector_type(2)));
__device__ __forceinline__ f32x2 gelu_pk(f32x2 v) {
    const f32x2 av = __builtin_elementwise_abs(v), d = av * 0.2316418882f + 1.0f;
    f32x2 t; t.x = __builtin_amdgcn_rcpf(d.x); t.y = __builtin_amdgcn_rcpf(d.y);
    f32x2 q = t * 0.5307027145f + (-0.7265760135f); q = q * t + 0.7107068705f; q = q * t + (-0.142248368f); q = q * t + 0.127414796f; q = q * t;
    const f32x2 s = (v * v) * (-0.72134752044f);
    f32x2 e; e.x = __builtin_amdgcn_exp2f(s.x); e.y = __builtin_amdgcn_exp2f(s.y);
    const f32x2 m = v * (q * e), r = v - m;
    f32x2 o; o.x = v.x < 0.f ? m.x : r.x; o.y = v.y < 0.f ? m.y : r.y; return o;
}

template <int ACT  > struct EpiBf16 {
    static constexpr bool PERM = true, AFTER_DRAIN = false; static_assert(ACT == 0 || ACT == 1, "EpiBf16: ACT is 0 (none) or 1 (gelu_pk)");
    bf16_t* O; int ldc; const float* bias; int split_cols; size_t split_stride; float scale0;
    __device__ __forceinline__ void operator()(const f32x4 (&acc)[2][2][4][2], const Unit& u, int wr, int wc, int fr, int fq) const {
        const int row0 = u.pm * BM + wr * 64 + fr; int colt = u.pn * BM; bf16_t* base = O;
        float sc = 1.f; if (split_cols) { const int t = colt / split_cols; base += (size_t)t * split_stride; colt -= t * split_cols; if (t == 0) sc = scale0; }
        const int col0 = colt + wc * 32 + 8 * fq, bcol0 = u.pn * BM + wc * 32 + 8 * fq;
        f32x4 bv[2][2];
#pragma unroll
        for (int bj = 0; bj < 2; ++bj)
#pragma unroll
            for (int n = 0; n < 2; ++n) bv[bj][n] = bias ? *(const f32x4*)(bias + bcol0 + bj * HALF + 4 * n) : (f32x4){0.f, 0.f, 0.f, 0.f};
#pragma unroll
        for (int ai = 0; ai < 2; ++ai)
#pragma unroll
            for (int m = 0; m < 4; ++m) { bf16_t* rowp = base + (size_t)(row0 + ai * HALF + m * 16) * ldc + col0;
#pragma unroll
                for (int bj = 0; bj < 2; ++bj) { f32x4 v0 = acc[ai][bj][m][0] + bv[bj][0], v1 = acc[ai][bj][m][1] + bv[bj][1];
                    if (ACT == 1) { f32x2 a = gelu_pk((f32x2){v0[0], v0[1]}), b = gelu_pk((f32x2){v0[2], v0[3]}), c = gelu_pk((f32x2){v1[0], v1[1]}), d = gelu_pk((f32x2){v1[2], v1[3]});
                        v0 = (f32x4){a.x, a.y, b.x, b.y}; v1 = (f32x4){c.x, c.y, d.x, d.y}; }
                    v0 = v0 * sc; v1 = v1 * sc; u32x4 w; w.x = cvt_pk_bf16(v0[0], v0[1]); w.y = cvt_pk_bf16(v0[2], v0[3]); w.z = cvt_pk_bf16(v1[0], v1[1]); w.w = cvt_pk_bf16(v1[2], v1[3]);
                    *(u32x4*)(rowp + bj * HALF) = w; } }
    }
};

struct PanelStats {
    unsigned* xbuf;
    unsigned* cnt;
    unsigned* tmo;
    int ntn; float eps;
    unsigned code;
    __device__ __forceinline__ bool run(const f32x4 (&v)[2][2][4][2], const Unit& u, int wr, int wc, int fr, int fq, PG8_LAS unsigned char* lds, int wid, int lane) const {
        typedef float f32x2v __attribute__((ext_vector_type(2)));
        PG8_LAS f32x2v* P = (PG8_LAS f32x2v*)lds;
        PG8_LAS f32x2v* S = (PG8_LAS f32x2v*)(lds + 8192);
        PG8_LAS unsigned* flag = (PG8_LAS unsigned*)(lds + 8192 + 2048);
#pragma unroll
        for (int ai = 0; ai < 2; ++ai)
#pragma unroll
            for (int m = 0; m < 4; ++m) {
                float s = 0.f;
#pragma unroll
                for (int bj = 0; bj < 2; ++bj)
#pragma unroll
                    for (int n = 0; n < 2; ++n) { const f32x4 x = v[ai][bj][m][n]; s += (x[0] + x[1]) + (x[2] + x[3]); }
                s += __shfl_xor(s, 16); s += __shfl_xor(s, 32);
                const float mw = s * (1.0f / 64.0f); float q = 0.f;
#pragma unroll
                for (int bj = 0; bj < 2; ++bj)
#pragma unroll
                    for (int n = 0; n < 2; ++n) { const f32x4 d = v[ai][bj][m][n] - mw; q += (d[0] * d[0] + d[1] * d[1]) + (d[2] * d[2] + d[3] * d[3]); }
                q += __shfl_xor(q, 16); q += __shfl_xor(q, 32);
                if (fq == 0) P[(ai * HALF + wr * 64 + m * 16 + fr) * 4 + wc] = (f32x2v){mw, q};
            }
        asm volatile("s_waitcnt lgkmcnt(0)" ::: "memory"); __builtin_amdgcn_s_barrier(); asm volatile("" ::: "memory");
#if defined(BROKEN_EXCHANGE_NO_WAIT)
#warning BROKEN CONTROL BUILD: the row-statistics exchange does not wait; results are wrong by design
        if (blockIdx.x >= 64) { const long long t0_ = clock64(); while (clock64() - t0_ < 60000) __builtin_amdgcn_s_sleep(8); }
#endif
        const int row = wid * 32 + (lane & 31);
        if (lane < 32) {
            const f32x2v a = P[row * 4 + 0], b = P[row * 4 + 1], c = P[row * 4 + 2], d = P[row * 4 + 3];
            const float mt = (a.x + b.x + c.x + d.x) * 0.25f;
            const float da = a.x - mt, db = b.x - mt, dc = c.x - mt, dd = d.x - mt;
            const float m2 = (a.y + b.y) + (c.y + d.y) + 64.0f * ((da * da + db * db) + (dc * dc + dd * dd));
            unsigned long long* slot = (unsigned long long*)xbuf + ((size_t)(u.pm * BM + row) * 4 + u.pn);
            __hip_atomic_store(slot, ((unsigned long long)__float_as_uint(m2) << 32) | __float_as_uint(mt), __ATOMIC_RELAXED, __HIP_MEMORY_SCOPE_AGENT);
        }
        asm volatile("s_waitcnt vmcnt(0)" ::: "memory");
        if (lane == 0) __hip_atomic_fetch_add(cnt + 64 * u.pm, 1u, __ATOMIC_RELAXED, __HIP_MEMORY_SCOPE_AGENT);
        if (wid == 0) {
            bool dead = false; const unsigned long long t0 = __builtin_amdgcn_s_memrealtime(); const unsigned want = 8u * (unsigned)ntn;
            for (;;) {
#if defined(BROKEN_EXCHANGE_NO_WAIT)
                break;
#endif
                if ((unsigned)__builtin_amdgcn_readfirstlane(__hip_atomic_load(cnt + 64 * u.pm, __ATOMIC_RELAXED, __HIP_MEMORY_SCOPE_AGENT)) >= want) break;
                if (__builtin_amdgcn_s_memrealtime() - t0 > 2000000ull) {
                    if (lane == 0) { unsigned expect = 0u; __hip_atomic_compare_exchange_strong(tmo + 1, &expect, code | (unsigned)(u.pm & 0xff), __ATOMIC_RELAXED, __ATOMIC_RELAXED, __HIP_MEMORY_SCOPE_AGENT);
                                     __hip_atomic_store(tmo, 1u, __ATOMIC_RELAXED, __HIP_MEMORY_SCOPE_AGENT); }
                    dead = true; break; }
                __builtin_amdgcn_s_sleep(2);
            }
            __builtin_amdgcn_fence(__ATOMIC_ACQUIRE, "agent");
            if (lane == 0) flag[0] = dead ? 1u : 0u;
        }
        asm volatile("s_waitcnt vmcnt(0) lgkmcnt(0)" ::: "memory"); __builtin_amdgcn_s_barrier(); asm volatile("" ::: "memory");
        const bool bad = flag[0] != 0u;
        if (lane < 32) {
            const unsigned long long* slot = (const unsigned long long*)xbuf + (size_t)(u.pm * BM + row) * 4; float mt[4], m2[4]; float ms = 0.f;
#pragma unroll
            for (int t = 0; t < 4; ++t) { if (t < ntn) { const unsigned long long w = __hip_atomic_load(slot + t, __ATOMIC_RELAXED, __HIP_MEMORY_SCOPE_AGENT); mt[t] = __uint_as_float((unsigned)w); m2[t] = __uint_as_float((unsigned)(w >> 32)); } else { mt[t] = 0.f; m2[t] = 0.f; } ms += mt[t]; }
            const float mean = ms / (float)ntn; float q = 0.f;
#pragma unroll
            for (int t = 0; t < 4; ++t) if (t < ntn) { const float dm = mt[t] - mean; q += m2[t] + 256.0f * dm * dm; }
            S[row] = (f32x2v){mean, 1.0f / sqrtf(q / (256.0f * (float)ntn) + eps)};
        }
        asm volatile("s_waitcnt lgkmcnt(0)" ::: "memory"); __builtin_amdgcn_s_barrier(); asm volatile("" ::: "memory");
        return bad;
    }
};
struct EpiLnRes {
    static constexpr bool PERM = false, AFTER_DRAIN = true;
    const float* base; float* out; int ldc; const float* bias; PanelStats st; unsigned poison;
    __device__ __forceinline__ void fused(f32x4 (&acc)[2][2][4][2], const Unit& u, int wr, int wc, int fr, int fq, PG8_LAS unsigned char* lds, int wid, int lane) const {
        typedef float f32x2v __attribute__((ext_vector_type(2)));
        const PG8_LAS f32x2v* S = (const PG8_LAS f32x2v*)(lds + 8192);
        const int col0 = u.pn * BM + wc * 32 + 4 * fq;
#pragma unroll
        for (int bj = 0; bj < 2; ++bj)
#pragma unroll
            for (int n = 0; n < 2; ++n) { const f32x4 bv = bias ? *(const f32x4*)(bias + col0 + bj * HALF + n * 16) : (f32x4){0.f, 0.f, 0.f, 0.f};
#pragma unroll
                for (int ai = 0; ai < 2; ++ai)
#pragma unroll
                    for (int m = 0; m < 4; ++m) acc[ai][bj][m][n] += bv; }
        f32x4 pre[4][2][2];
#pragma unroll
        for (int m = 0; m < 4; ++m) { const size_t off = (size_t)(u.pm * BM + wr * 64 + m * 16 + fr) * ldc + col0;
#pragma unroll
            for (int bj = 0; bj < 2; ++bj)
#pragma unroll
                for (int n = 0; n < 2; ++n) pre[m][bj][n] = *(const f32x4*)(base + off + bj * HALF + n * 16); }
        const bool bad = st.run(acc, u, wr, wc, fr, fq, lds, wid, lane) || poison != 0u;
        const float qnan = __builtin_nanf("");
#pragma unroll
        for (int ai = 0; ai < 2; ++ai)
#pragma unroll
            for (int m = 0; m < 4; ++m) { const int r = ai * HALF + wr * 64 + m * 16 + fr; const f32x2v sr = S[r]; const size_t off = (size_t)(u.pm * BM + r) * ldc + col0;
#pragma unroll
                for (int bj = 0; bj < 2; ++bj)
#pragma unroll
                    for (int n = 0; n < 2; ++n) { const f32x4 bs = ai == 0 ? pre[m][bj][n] : *(const f32x4*)(base + off + bj * HALF + n * 16); f32x4 o = bs + (acc[ai][bj][m][n] - sr.x) * sr.y;
                        if (bad) o = (f32x4){qnan, qnan, qnan, qnan}; *(f32x4*)(out + off + bj * HALF + n * 16) = o; }
                if (m & 1) asm volatile("" ::: "memory"); }
    }
};
struct EpiLnResLn {
    static constexpr bool PERM = false, AFTER_DRAIN = true;
    const float* base; float* out; bf16_t* xn; int ldc; const float* bias; PanelStats st1, st2; unsigned poison;
    __device__ __forceinline__ void fused(f32x4 (&acc)[2][2][4][2], const Unit& u, int wr, int wc, int fr, int fq, PG8_LAS unsigned char* lds, int wid, int lane) const {
        typedef float f32x2v __attribute__((ext_vector_type(2))); typedef unsigned u32x2v __attribute__((ext_vector_type(2)));
        const PG8_LAS f32x2v* S = (const PG8_LAS f32x2v*)(lds + 8192);
        const int col0 = u.pn * BM + wc * 32 + 4 * fq;
#pragma unroll
        for (int bj = 0; bj < 2; ++bj)
#pragma unroll
            for (int n = 0; n < 2; ++n) { const f32x4 bv = bias ? *(const f32x4*)(bias + col0 + bj * HALF + n * 16) : (f32x4){0.f, 0.f, 0.f, 0.f};
#pragma unroll
                for (int ai = 0; ai < 2; ++ai)
#pragma unroll
                    for (int m = 0; m < 4; ++m) acc[ai][bj][m][n] += bv; }
        bool bad = st1.run(acc, u, wr, wc, fr, fq, lds, wid, lane) || poison != 0u;
        const float qnan = __builtin_nanf("");
#pragma unroll
        for (int ai = 0; ai < 2; ++ai)
#pragma unroll
            for (int m = 0; m < 4; ++m) { const int r = ai * HALF + wr * 64 + m * 16 + fr; const f32x2v sr = S[r]; const size_t off = (size_t)(u.pm * BM + r) * ldc + col0;
#pragma unroll
                for (int bj = 0; bj < 2; ++bj)
#pragma unroll
                    for (int n = 0; n < 2; ++n) { const f32x4 bs = *(const f32x4*)(base + off + bj * HALF + n * 16); acc[ai][bj][m][n] = bs + (acc[ai][bj][m][n] - sr.x) * sr.y; }
                asm volatile("" : "+v"(acc[ai][0][m][0]), "+v"(acc[ai][0][m][1]), "+v"(acc[ai][1][m][0]), "+v"(acc[ai][1][m][1]));
                if (m & 1) asm volatile("" ::: "memory"); }
        const bool bad1 = bad;
        bad = st2.run(acc, u, wr, wc, fr, fq, lds, wid, lane) || bad;
#pragma unroll
        for (int ai = 0; ai < 2; ++ai)
#pragma unroll
            for (int m = 0; m < 4; ++m) { const int r = ai * HALF + wr * 64 + m * 16 + fr; const f32x2v sr = S[r]; const size_t off = (size_t)(u.pm * BM + r) * ldc + col0;
#pragma unroll
                for (int bj = 0; bj < 2; ++bj)
#pragma unroll
                    for (int n = 0; n < 2; ++n) { const f32x4 x1 = acc[ai][bj][m][n]; *(f32x4*)(out + off + bj * HALF + n * 16) = bad1 ? (f32x4){qnan, qnan, qnan, qnan} : x1;
                        const f32x4 o = (x1 - sr.x) * sr.y; u32x2v w; w.x = cvt_pk_bf16(o[0], o[1]); w.y = cvt_pk_bf16(o[2], o[3]);
                        if (bad) { w.x = 0x7fc07fc0u; w.y = 0x7fc07fc0u; } *(u32x2v*)(xn + off + bj * HALF + n * 16) = w; }
                asm volatile("" ::: "memory"); }
    }
};

template <class Epi, class Sched, bool ALIGN_EPI = false, bool SP2 = false>
__device__ __forceinline__ void gemm_phase(PG8_LAS unsigned char* lds, const Gemm g, const Sched& S, const Epi& E) {
    const int tid = threadIdx.x, wid = __builtin_amdgcn_readfirstlane(tid >> 6), lane = tid & 63, wr = wid >> 2, wc = wid & 3, fr = lane & 15, fq = lane >> 4;
    const int K = g.K, nt = K / BK;
    unsigned voffA[2], voffB[2];
#pragma unroll
    for (int i = 0; i < 2; ++i) { int R, C; stage_rc(tid * 16 + i * 8192, R, C); const int Rb = Epi::PERM ? ((R & ~31) + perm32(R & 31)) : R;
        voffA[i] = (unsigned)(R * K + C) * 2u; voffB[i] = (unsigned)(Rb * K + C) * 2u; }
    const size_t kstep = (size_t)(BK * 2);
    const size_t hstep = (size_t)HALF * K * 2;
    const size_t tstep = 2 * hstep;
    const unsigned ldsw = (unsigned)wid * 1024u;
    const int aoff = lds_byte(wr * 64 + fr, fq * 8), boff = lds_byte(wc * 32 + fr, fq * 8);
#define PG8_SA(b, h) (((b) * 2 + (h)) * HTB)
#define PG8_SB(b, h) ((4 + (b) * 2 + (h)) * HTB)
#define PG8_STAGE(bufoff, gbase, voff) do { _Pragma("unroll") for (int _i = 0; _i < 2; ++_i) \
        __builtin_amdgcn_global_load_lds((const unsigned*)((const char*)(gbase) + (voff)[_i]), (PG8_LAS unsigned*)(lds + (bufoff) + ldsw + _i * 8192), 16, 0, 0); } while (0)
#define PG8_LDA(dst, b, h) do { _Pragma("unroll") for (int m = 0; m < 4; ++m) _Pragma("unroll") for (int k = 0; k < 2; ++k) dst[m][k] = *(const PG8_LAS bf16x8*)(lds + PG8_SA(b, h) + aoff + m * 2048 + k * 1024); } while (0)
#define PG8_LDB(dst, b, h) do { _Pragma("unroll") for (int n = 0; n < 2; ++n) _Pragma("unroll") for (int k = 0; k < 2; ++k) dst[n][k] = *(const PG8_LAS bf16x8*)(lds + PG8_SB(b, h) + boff + n * 2048 + k * 1024); } while (0)
#define PG8_MMA(ai, bj, At, Bt) do { __builtin_amdgcn_s_setprio(1); _Pragma("unroll") for (int m = 0; m < 4; ++m) _Pragma("unroll") for (int n = 0; n < 2; ++n) _Pragma("unroll") for (int k = 0; k < 2; ++k) \
        acc[ai][bj][m][n] = __builtin_amdgcn_mfma_f32_16x16x32_bf16(Bt[n][k], At[m][k], acc[ai][bj][m][n], 0, 0, 0); __builtin_amdgcn_s_setprio(0); } while (0)
#define PG8_WAIT_V(n) asm volatile("s_waitcnt vmcnt(" #n ")" ::: "memory")
#define PG8_WAIT_L(n) asm volatile("s_waitcnt lgkmcnt(" #n ")" ::: "memory")
#define PG8_BAR __builtin_amdgcn_s_barrier()
#define PG8_SCHED __builtin_amdgcn_sched_barrier(0)
    Unit cur, nxt; int ui = 0;
    if (!S.next(0, cur)) return;
    f32x4 acc[2][2][4][2];
#pragma unroll
    for (int a = 0; a < 2; ++a)
#pragma unroll
        for (int b = 0; b < 2; ++b)
#pragma unroll
            for (int m = 0; m < 4; ++m)
#pragma unroll
                for (int n = 0; n < 2; ++n) acc[a][b][m][n] = (f32x4){0.f, 0.f, 0.f, 0.f};
    bf16x8 At[4][2], B0[2][2], B1[2][2];
    const char* cA = (const char*)g.A + (size_t)cur.pm * tstep; const char* cB = (const char*)g.Bt + (size_t)cur.pn * tstep;
    S.a_ready(cur);
    if constexpr (SP2) {
        PG8_STAGE(PG8_SB(0, 0), cB, voffB); PG8_STAGE(PG8_SB(0, 1), cB + hstep, voffB); PG8_STAGE(PG8_SA(0, 0), cA, voffA); PG8_STAGE(PG8_SA(0, 1), cA + hstep, voffA);
        if (wr == 1) PG8_BAR;
        PG8_WAIT_V(2); PG8_BAR;
        PG8_STAGE(PG8_SB(1, 0), cB + kstep, voffB); PG8_STAGE(PG8_SA(1, 0), cA + kstep, voffA); PG8_STAGE(PG8_SB(1, 1), cB + hstep + kstep, voffB);
        PG8_WAIT_V(6); PG8_BAR;
    } else {
        PG8_STAGE(PG8_SB(0, 0), cB, voffB); PG8_STAGE(PG8_SA(0, 0), cA, voffA); PG8_STAGE(PG8_SB(0, 1), cB + hstep, voffB); PG8_STAGE(PG8_SA(0, 1), cA + hstep, voffA);
        if (wr == 1) PG8_BAR;
        PG8_WAIT_V(4); PG8_BAR;
        PG8_STAGE(PG8_SB(1, 0), cB + kstep, voffB); PG8_STAGE(PG8_SA(1, 0), cA + kstep, voffA); PG8_STAGE(PG8_SB(1, 1), cB + hstep + kstep, voffB);
        PG8_WAIT_V(6); PG8_BAR;
    }
    for (;;) {
        const bool has_next = S.next(ui + 1, nxt);
        const char* nA = has_next ? (const char*)g.A + (size_t)nxt.pm * tstep : cA; const char* nB = has_next ? (const char*)g.Bt + (size_t)nxt.pn * tstep : cB;
        for (int t = 0; t < nt; t += 2) {
            const bool last = (t == nt - 2);
            const char* a1 = cA + (size_t)(t + 1) * kstep;
            const char* a2 = last ? nA : cA + (size_t)(t + 2) * kstep; const char* b2 = last ? nB : cB + (size_t)(t + 2) * kstep;
            const char* a3 = a2 + kstep; const char* b3 = b2 + kstep;
            if (last && has_next) S.a_ready(nxt);
            if constexpr (SP2) {
            PG8_LDB(B0, 0, 0); PG8_LDB(B1, 0, 1); PG8_SCHED; PG8_LDA(At, 0, 0); PG8_STAGE(PG8_SA(1, 1), a1 + hstep, voffA);
            PG8_WAIT_V(8); PG8_WAIT_L(0); PG8_BAR; PG8_MMA(0, 0, At, B0); PG8_MMA(0, 1, At, B1); PG8_BAR; PG8_SCHED;
            PG8_LDA(At, 0, 1); PG8_STAGE(PG8_SB(0, 0), b2, voffB); PG8_STAGE(PG8_SB(0, 1), b2 + hstep, voffB); PG8_STAGE(PG8_SA(0, 0), a2, voffA);
            PG8_WAIT_V(8); PG8_WAIT_L(0); PG8_BAR; PG8_MMA(1, 0, At, B0); PG8_MMA(1, 1, At, B1); PG8_BAR; PG8_SCHED;
            PG8_LDB(B0, 1, 0); PG8_LDB(B1, 1, 1); PG8_SCHED; PG8_LDA(At, 1, 0); PG8_STAGE(PG8_SA(0, 1), a2 + hstep, voffA);
            PG8_WAIT_V(8); PG8_WAIT_L(0); PG8_BAR; PG8_MMA(0, 0, At, B0); PG8_MMA(0, 1, At, B1); PG8_BAR; PG8_SCHED;
            PG8_LDA(At, 1, 1); PG8_STAGE(PG8_SB(1, 0), b3, voffB); PG8_STAGE(PG8_SB(1, 1), b3 + hstep, voffB); PG8_STAGE(PG8_SA(1, 0), a3, voffA);
            PG8_WAIT_V(8); PG8_WAIT_L(0); PG8_BAR; PG8_MMA(1, 0, At, B0); PG8_MMA(1, 1, At, B1); PG8_BAR; PG8_SCHED;
            } else {
            PG8_LDB(B0, 0, 0); PG8_SCHED; PG8_LDA(At, 0, 0); PG8_STAGE(PG8_SA(1, 1), a1 + hstep, voffA);
            PG8_WAIT_L(8); PG8_BAR; PG8_WAIT_L(0); PG8_MMA(0, 0, At, B0); PG8_BAR; PG8_SCHED;
            PG8_LDB(B1, 0, 1); PG8_STAGE(PG8_SB(0, 0), b2, voffB);
            PG8_BAR; PG8_WAIT_L(0); PG8_MMA(0, 1, At, B1); PG8_BAR;
            PG8_LDA(At, 0, 1); PG8_STAGE(PG8_SA(0, 0), a2, voffA);
            PG8_BAR; PG8_WAIT_L(0); PG8_MMA(1, 0, At, B0); PG8_BAR; PG8_SCHED;
            PG8_STAGE(PG8_SB(0, 1), b2 + hstep, voffB);
            PG8_WAIT_V(6); PG8_BAR; PG8_MMA(1, 1, At, B1); PG8_BAR;
            PG8_LDB(B0, 1, 0); PG8_SCHED; PG8_LDA(At, 1, 0); PG8_STAGE(PG8_SA(0, 1), a2 + hstep, voffA);
            PG8_WAIT_L(8); PG8_BAR; PG8_WAIT_L(0); PG8_MMA(0, 0, At, B0); PG8_BAR; PG8_SCHED;
            PG8_LDB(B1, 1, 1); PG8_STAGE(PG8_SB(1, 0), b3, voffB);
            PG8_BAR; PG8_WAIT_L(0); PG8_MMA(0, 1, At, B1); PG8_BAR;
            PG8_LDA(At, 1, 1); PG8_STAGE(PG8_SA(1, 0), a3, voffA);
            PG8_BAR; PG8_WAIT_L(0); PG8_MMA(1, 0, At, B0); PG8_BAR; PG8_SCHED;
            PG8_STAGE(PG8_SB(1, 1), b3 + hstep, voffB);
            PG8_WAIT_V(6); PG8_BAR; PG8_MMA(1, 1, At, B1); PG8_BAR;
            }
        }
        if constexpr (ALIGN_EPI) { if (wr == 0) PG8_BAR; }
        if constexpr (!Epi::AFTER_DRAIN) { E(acc, cur, wr, wc, fr, fq); S.done(cur); }
        if (!has_next) break;
#pragma unroll
        for (int a = 0; a < 2; ++a)
#pragma unroll
            for (int b = 0; b < 2; ++b)
#pragma unroll
                for (int m = 0; m < 4; ++m)
#pragma unroll
                    for (int n = 0; n < 2; ++n) acc[a][b][m][n] = (f32x4){0.f, 0.f, 0.f, 0.f};
        cur = nxt; cA = nA; cB = nB; ++ui;
        if constexpr (ALIGN_EPI) { if (wr == 1) PG8_BAR; }
    }
    PG8_WAIT_V(0);
    if constexpr (!ALIGN_EPI) { if (wr == 0) PG8_BAR; }
    PG8_BAR;
    if constexpr (Epi::AFTER_DRAIN) { E.fused(acc, cur, wr, wc, fr, fq, lds, wid, lane); S.done(cur); }
#undef PG8_SA
#undef PG8_SB
#undef PG8_STAGE
#undef PG8_LDA
#undef PG8_LDB
#undef PG8_MMA
#undef PG8_WAIT_V
#undef PG8_WAIT_L
#undef PG8_BAR
#undef PG8_SCHED
}
}

namespace pg8 {
constexpr float RMS_EPS = 1e-6f;
__device__ __forceinline__ float row_rstd(const float* ss, int row) {
    const f32x4* p = (const f32x4*)(ss + (size_t)row * 16); const f32x4 a = p[0], b = p[1], c = p[2], d = p[3];
    const float s = (((a[0] + a[1]) + (a[2] + a[3])) + ((b[0] + b[1]) + (b[2] + b[3]))) + (((c[0] + c[1]) + (c[2] + c[3])) + ((d[0] + d[1]) + (d[2] + d[3])));
    return 1.0f / sqrtf(s * (1.0f / 1024.0f) + RMS_EPS);
}
__device__ __forceinline__ float silu_f(float g) { return g * __builtin_amdgcn_rcpf(1.0f + __builtin_amdgcn_exp2f(-1.4426950408889634f * g)); }
struct EpiSwiGLU {
    static constexpr bool PERM = true, AFTER_DRAIN = false;
    bf16_t* H; int ldh; const float* ss;
    __device__ __forceinline__ void operator()(const f32x4 (&acc)[2][2][4][2], const Unit& u, int wr, int wc, int fr, int fq) const {
        const int row0 = u.pm * BM + wr * 64 + fr, col0 = u.pn * 128 + wc * 32 + 8 * fq;
#pragma unroll
        for (int ai = 0; ai < 2; ++ai)
#pragma unroll
            for (int m = 0; m < 4; ++m) { const int row = row0 + ai * HALF + m * 16; const float rs = row_rstd(ss, row);
                float h[8];
#pragma unroll
                for (int n = 0; n < 2; ++n)
#pragma unroll
                    for (int e = 0; e < 4; ++e) { const float g = acc[ai][0][m][n][e] * rs, up = acc[ai][1][m][n][e] * rs; h[n * 4 + e] = silu_f(g) * up; }
                u32x4 w; w.x = cvt_pk_bf16(h[0], h[1]); w.y = cvt_pk_bf16(h[2], h[3]); w.z = cvt_pk_bf16(h[4], h[5]); w.w = cvt_pk_bf16(h[6], h[7]);
                *(u32x4*)(H + (size_t)row * ldh + col0) = w; }
    }
};
struct EpiProj {
    static constexpr bool PERM = true, AFTER_DRAIN = false;
    bf16_t* PA; bf16_t* PR; const float* ss;
    __device__ __forceinline__ void operator()(const f32x4 (&acc)[2][2][4][2], const Unit& u, int wr, int wc, int fr, int fq) const {
        const int row0 = u.pm * BM + wr * 64 + fr; const int cin = wc * 32 + 8 * fq;
        bf16_t* base; int ld;
        if (u.pn < 4) { base = PA + u.pn * 256 + cin; ld = 1024; } else { base = PR + (u.pn - 4) * 256 + cin; ld = 2560; }
#pragma unroll
        for (int ai = 0; ai < 2; ++ai)
#pragma unroll
            for (int m = 0; m < 4; ++m) { const int row = row0 + ai * HALF + m * 16; const float rs = row_rstd(ss, row);
#pragma unroll
                for (int bj = 0; bj < 2; ++bj) { const f32x4 v0 = acc[ai][bj][m][0] * rs, v1 = acc[ai][bj][m][1] * rs;
                    u32x4 w; w.x = cvt_pk_bf16(v0[0], v0[1]); w.y = cvt_pk_bf16(v0[2], v0[3]); w.z = cvt_pk_bf16(v1[0], v1[1]); w.w = cvt_pk_bf16(v1[2], v1[3]);
                    *(u32x4*)(base + (size_t)row * ld + bj * HALF) = w; } }
    }
};
template <bool BASE_BF16, bool OUT_F32> struct EpiResid {
    static constexpr bool PERM = true, AFTER_DRAIN = false;
    const void* base; void* out; float* ss; float scale;
    __device__ __forceinline__ void operator()(const f32x4 (&acc)[2][2][4][2], const Unit& u, int wr, int wc, int fr, int fq) const {
        const int row0 = u.pm * BM + wr * 64 + fr, col0 = u.pn * BM + wc * 32 + 8 * fq;
#pragma unroll
        for (int ai = 0; ai < 2; ++ai)
#pragma unroll
            for (int m = 0; m < 4; ++m) { const int row = row0 + ai * HALF + m * 16; const size_t off = (size_t)row * 1024 + col0; float sq = 0.f;
#pragma unroll
                for (int bj = 0; bj < 2; ++bj) {
                    f32x4 b0, b1;
                    if (BASE_BF16) { const u32x4 r = *(const u32x4*)((const bf16_t*)base + off + bj * HALF);
                        b0 = (f32x4){__uint_as_float(r.x << 16), __uint_as_float(r.x & 0xffff0000u), __uint_as_float(r.y << 16), __uint_as_float(r.y & 0xffff0000u)};
                        b1 = (f32x4){__uint_as_float(r.z << 16), __uint_as_float(r.z & 0xffff0000u), __uint_as_float(r.w << 16), __uint_as_float(r.w & 0xffff0000u)}; }
                    else { b0 = *(const f32x4*)((const float*)base + off + bj * HALF); b1 = *(const f32x4*)((const float*)base + off + bj * HALF + 4); }
                    const f32x4 v0 = b0 + acc[ai][bj][m][0] * scale, v1 = b1 + acc[ai][bj][m][1] * scale;
                    sq += ((v0[0] * v0[0] + v0[1] * v0[1]) + (v0[2] * v0[2] + v0[3] * v0[3])) + ((v1[0] * v1[0] + v1[1] * v1[1]) + (v1[2] * v1[2] + v1[3] * v1[3]));
                    if (OUT_F32) { *(f32x4*)((float*)out + off + bj * HALF) = v0; *(f32x4*)((float*)out + off + bj * HALF + 4) = v1; }
                    else { u32x4 w; w.x = cvt_pk_bf16(v0[0], v0[1]); w.y = cvt_pk_bf16(v0[2], v0[3]); w.z = cvt_pk_bf16(v1[0], v1[1]); w.w = cvt_pk_bf16(v1[2], v1[3]);
                        *(u32x4*)((bf16_t*)out + off + bj * HALF) = w; } }
                if (ss) { sq += __shfl_xor(sq, 16); sq += __shfl_xor(sq, 32); if (fq == 0) ss[(size_t)row * 16 + u.pn * 4 + wc] = sq; } }
    }
};
}

namespace att {
using bf16 = __hip_bfloat16;
constexpr int   D = 128, NW = 8, QBLK = 32, KVBLK = 64;
constexpr float SCALE = 0.088388347648318440f;
constexpr float THR = 8.f;
constexpr int SDEPTH = 2;
constexpr int LDQ = 1024, LDK = 1024, LDO = 512;
constexpr size_t SHM_V = KVBLK * D * 2, SHM_K = KVBLK * D * 2, SHM_ATTN = 2 * SHM_V + 2 * SHM_K + NW * 64 * 4;
using bf16x8 = __attribute__((ext_vector_type(8))) short;
using s16x4  = __attribute__((ext_vector_type(4))) short;
using f32x16 = __attribute__((ext_vector_type(16))) float;
using f32x8  = __attribute__((ext_vector_type(8))) float;
using u32x4  = __attribute__((ext_vector_type(4))) unsigned;
#define KSWZ(row, colB) ((row) * 256 + ((colB) ^ (((row) & 7) << 4)))
#define SBAR() __builtin_amdgcn_sched_barrier(0)
__device__ __forceinline__ int crow(int r, int hi) { return (r & 3) + 8 * (r >> 2) + 4 * hi; }
__device__ __forceinline__ unsigned cvtpk(float lo, float hi) {
  unsigned r; asm volatile("v_cvt_pk_bf16_f32 %0, %1, %2" : "=v"(r) : "v"(lo), "v"(hi)); return r;
}
template <typename TIn> struct Stage;
template <> struct Stage<bf16>  { using T = bf16x8;
  __device__ static __forceinline__ T ld8(const bf16* p) { return *reinterpret_cast<const bf16x8*>(p); }
  __device__ static __forceinline__ bf16x8 tobf(T x) { return x; } };
template <> struct Stage<float> { using T = f32x8;
  __device__ static __forceinline__ T ld8(const float* p) { return *reinterpret_cast<const f32x8*>(p); }
  __device__ static __forceinline__ bf16x8 tobf(T x) {
    u32x4 w = {cvtpk(x[0], x[1]), cvtpk(x[2], x[3]), cvtpk(x[4], x[5]), cvtpk(x[6], x[7])}; return *reinterpret_cast<bf16x8*>(&w); } };

__device__ __forceinline__ void partialSM(f32x16& p0, f32x16& p1, float& m_reg, float& mn, float& alpha) {
  constexpr float C = SCALE * 1.4426950408889634f;
  float pmax = p0[0]; for (int r = 1; r < 16; ++r) pmax = fmaxf(pmax, p0[r]); for (int r = 0; r < 16; ++r) pmax = fmaxf(pmax, p1[r]);
  { auto rr = __builtin_amdgcn_permlane32_swap(__float_as_uint(pmax), __float_as_uint(pmax), false, false);
    pmax = fmaxf(__uint_as_float(rr[0]), __uint_as_float(rr[1])); }
  if (__builtin_expect(__all(pmax - m_reg <= THR / SCALE), 1)) { mn = m_reg; alpha = 1.f; }
  else { mn = fmaxf(m_reg, pmax); alpha = __builtin_amdgcn_exp2f((m_reg - mn) * C); m_reg = mn; }
  float mnC = -mn * C;
  for (int r = 0; r < 16; ++r) p0[r] = fmaf(p0[r], C, mnC); for (int r = 0; r < 16; ++r) p1[r] = fmaf(p1[r], C, mnC);
  for (int r = 0; r < 16; ++r) p0[r] = __builtin_amdgcn_exp2f(p0[r]);
}
__device__ __forceinline__ void finishSM(f32x16& p0, f32x16& p1, float alpha, float& l_reg, bf16x8& pa0, bf16x8& pa1, bf16x8& pa2, bf16x8& pa3) {
  for (int r = 0; r < 16; ++r) p1[r] = __builtin_amdgcn_exp2f(p1[r]);
  float ps = 0; for (int r = 0; r < 16; ++r) ps += p0[r]; for (int r = 0; r < 16; ++r) ps += p1[r];
  { auto rr = __builtin_amdgcn_permlane32_swap(__float_as_uint(ps), __float_as_uint(ps), false, false);
    ps = __uint_as_float(rr[0]) + __uint_as_float(rr[1]); }
  l_reg = l_reg * alpha + ps;
#define PK4(P, BASE, OUT) do { unsigned a0 = cvtpk(P[BASE + 0], P[BASE + 1]), a1 = cvtpk(P[BASE + 2], P[BASE + 3]);   \
    unsigned b0 = cvtpk(P[BASE + 4], P[BASE + 5]), b1 = cvtpk(P[BASE + 6], P[BASE + 7]);                              \
    auto r0 = __builtin_amdgcn_permlane32_swap(a0, b0, false, false); auto r1 = __builtin_amdgcn_permlane32_swap(a1, b1, false, false); \
    u32x4 w = {r0[0], r1[0], r0[1], r1[1]}; OUT = *reinterpret_cast<bf16x8*>(&w); } while (0)
  PK4(p0, 0, pa0); PK4(p0, 8, pa1); PK4(p1, 0, pa2); PK4(p1, 8, pa3);
#undef PK4
}
__device__ __forceinline__ void qkt(f32x16& p0, f32x16& p1, const bf16* Ks, const bf16x8* qr, int r32, int hi) {
  p0 = f32x16{}; p1 = f32x16{};
  for (int d0 = 0; d0 < 8; ++d0) { int cb = (d0 * 16 + hi * 8) * 2;
    bf16x8 b0 = *reinterpret_cast<const bf16x8*>((const char*)Ks + KSWZ(r32, cb));
    bf16x8 b1 = *reinterpret_cast<const bf16x8*>((const char*)Ks + KSWZ(32 + r32, cb));
    p0 = __builtin_amdgcn_mfma_f32_32x32x16_bf16(b0, qr[d0], p0, 0, 0, 0);
    p1 = __builtin_amdgcn_mfma_f32_32x32x16_bf16(b1, qr[d0], p1, 0, 0, 0); }
}
__device__ __forceinline__ int v_st(int k, int c) { const int kk = (k & ~0xC) | ((k & 4) << 1) | ((k & 8) >> 1); return ((kk >> 3) * 4 + (c >> 5)) * 512 + ((kk & 7) * 32 + (c & 31)) * 2; }
__device__ __forceinline__ int v_rd_base(int lane) { return ((lane & 3) << 3) | (((lane >> 2) & 3) << 6) | (((lane >> 4) & 1) << 5) | (((lane >> 5) & 1) << 8); }
constexpr int v_rd_off(int d0, int ks, int half) { return d0 * 512 + ks * 4096 + half * 2048; }
template <int OFF> __device__ __forceinline__ s16x4 tr_read(int vb) {
  s16x4 r; asm volatile("ds_read_b64_tr_b16 %0, %1 offset:%2" : "=&v"(r) : "v"(vb), "i"(OFF) : "memory"); return r;
}
template <int D0> __device__ __forceinline__ void pv_one(f32x16& od, int vb, bf16x8 pa0, bf16x8 pa1, bf16x8 pa2, bf16x8 pa3) {
  const s16x4 l0 = tr_read<v_rd_off(D0, 0, 0)>(vb), h0 = tr_read<v_rd_off(D0, 0, 1)>(vb), l1 = tr_read<v_rd_off(D0, 1, 0)>(vb), h1 = tr_read<v_rd_off(D0, 1, 1)>(vb);
  const s16x4 l2 = tr_read<v_rd_off(D0, 2, 0)>(vb), h2 = tr_read<v_rd_off(D0, 2, 1)>(vb), l3 = tr_read<v_rd_off(D0, 3, 0)>(vb), h3 = tr_read<v_rd_off(D0, 3, 1)>(vb);
  asm volatile("s_waitcnt lgkmcnt(0)" ::: "memory"); SBAR();
#define PK(L, H) (bf16x8){L[0], L[1], L[2], L[3], H[0], H[1], H[2], H[3]}
  od = __builtin_amdgcn_mfma_f32_32x32x16_bf16(pa0, PK(l0, h0), od, 0, 0, 0);
  od = __builtin_amdgcn_mfma_f32_32x32x16_bf16(pa1, PK(l1, h1), od, 0, 0, 0);
  od = __builtin_amdgcn_mfma_f32_32x32x16_bf16(pa2, PK(l2, h2), od, 0, 0, 0);
  od = __builtin_amdgcn_mfma_f32_32x32x16_bf16(pa3, PK(l3, h3), od, 0, 0, 0);
#undef PK
}
__device__ __forceinline__ void pv_d0(f32x16* o, int vb, bf16x8 pa0, bf16x8 pa1, bf16x8 pa2, bf16x8 pa3) {
  pv_one<0>(o[0], vb, pa0, pa1, pa2, pa3); pv_one<1>(o[1], vb, pa0, pa1, pa2, pa3); pv_one<2>(o[2], vb, pa0, pa1, pa2, pa3); pv_one<3>(o[3], vb, pa0, pa1, pa2, pa3);
}

template <typename TQ>
__device__ __forceinline__ void attn_dense_body(const TQ* __restrict__ Qb, const bf16* __restrict__ Kh, const bf16* __restrict__ Vh,
                                                float* __restrict__ Ob, int seq, char* lds) {
  using St = Stage<bf16>; using SQ = Stage<TQ>;
  const int tid = threadIdx.x, wid = tid >> 6, lane = tid & 63, r32 = lane & 31, hi = lane >> 5;
  bf16* V_lds = (bf16*)lds; bf16* K_lds = (bf16*)(lds + 2 * SHM_V);
  float* ws = (float*)(lds + 2 * SHM_V + 2 * SHM_K) + wid * 64; float* li_l = ws; float* al_l = ws + 32;
  float m_reg = -1e30f, l_reg = 0; f32x16 o[4] = {}; bf16x8 qr[8];
  const TQ* Qw = Qb + (long)(wid * QBLK + r32) * LDQ + hi * 8;
#pragma unroll
  for (int d0 = 0; d0 < 8; ++d0) qr[d0] = SQ::tobf(SQ::ld8(Qw + d0 * 16));
  const int sr = tid >> 4, sc = (tid & 15) * 8, vst0 = v_st(sr, sc), vst1 = v_st(32 + sr, sc);
  const int vb0 = (int)(uintptr_t)V_lds + v_rd_base(lane);
  struct { typename St::T vs0, vs1, ks0, ks1; } sr_[SDEPTH];
#define SLOAD(i, k0) do { sr_[i].vs0 = St::ld8(&Vh[(long)((k0) + sr) * LDK + sc]); sr_[i].vs1 = St::ld8(&Vh[(long)((k0) + 32 + sr) * LDK + sc]); \
    sr_[i].ks0 = St::ld8(&Kh[(long)((k0) + sr) * LDK + sc]); sr_[i].ks1 = St::ld8(&Kh[(long)((k0) + 32 + sr) * LDK + sc]); } while (0)
#define SWRITE(b, i) do { *(bf16x8*)((char*)V_lds + (b) * SHM_V + vst0) = St::tobf(sr_[i].vs0);          \
    *(bf16x8*)((char*)V_lds + (b) * SHM_V + vst1) = St::tobf(sr_[i].vs1); int kc = sc * 2;               \
    *(bf16x8*)((char*)K_lds + (b) * SHM_K + KSWZ(sr, kc)) = St::tobf(sr_[i].ks0);                       \
    *(bf16x8*)((char*)K_lds + (b) * SHM_K + KSWZ(32 + sr, kc)) = St::tobf(sr_[i].ks1); } while (0)
#define SWAIT() do { if constexpr (SDEPTH == 2) asm volatile("s_waitcnt vmcnt(4)" ::: "memory"); else asm volatile("s_waitcnt vmcnt(0)" ::: "memory"); } while (0)
#define RESC(a) do { if (__any((a) < 1.f)) { if (hi == 0) al_l[r32] = (a); asm volatile("s_waitcnt lgkmcnt(0)" ::: "memory"); \
    for (int d = 0; d < 4; ++d) for (int r = 0; r < 16; ++r) o[d][r] *= al_l[crow(r, hi)]; } } while (0)
  f32x16 pA0, pA1, pB0, pB1; float mnA, mnB, alA, alB; bf16x8 pa0, pa1, pa2, pa3; const int NT = seq / KVBLK;
  constexpr int SE = 0, SO = SDEPTH - 1;
  SLOAD(SE, 0); asm volatile("s_waitcnt vmcnt(0)" ::: "memory"); SWRITE(0, SE); __syncthreads();
  qkt(pA0, pA1, K_lds, qr, r32, hi); partialSM(pA0, pA1, m_reg, mnA, alA);
  SLOAD(SO, KVBLK); if constexpr (SDEPTH == 2) { if (2 < NT) SLOAD(SE, 2 * KVBLK); }
  SWAIT(); SWRITE(1, SO); __syncthreads();
  for (int j = 1; j + 1 < NT; j += 2) {
    SBAR(); qkt(pB0, pB1, (bf16*)((char*)K_lds + SHM_K), qr, r32, hi);
    finishSM(pA0, pA1, alA, l_reg, pa0, pa1, pa2, pa3); SBAR();
    SLOAD(SO, (j + SDEPTH) * KVBLK); SBAR();
    pv_d0(o, vb0, pa0, pa1, pa2, pa3); partialSM(pB0, pB1, m_reg, mnB, alB);
    __syncthreads(); SWAIT(); SWRITE(0, SE);
    RESC(alB); __syncthreads();
    SBAR(); qkt(pA0, pA1, K_lds, qr, r32, hi);
    finishSM(pB0, pB1, alB, l_reg, pa0, pa1, pa2, pa3); SBAR();
    if (SDEPTH == 1 || j + 3 < NT) SLOAD(SE, (j + 1 + SDEPTH) * KVBLK); SBAR();
    pv_d0(o, vb0 + (int)SHM_V, pa0, pa1, pa2, pa3); partialSM(pA0, pA1, m_reg, mnA, alA);
    __syncthreads(); SWAIT(); SWRITE(1, SO);
    RESC(alA); __syncthreads();
  }
  SBAR(); qkt(pB0, pB1, (bf16*)((char*)K_lds + SHM_K), qr, r32, hi);
  finishSM(pA0, pA1, alA, l_reg, pa0, pa1, pa2, pa3); SBAR();
  pv_d0(o, vb0, pa0, pa1, pa2, pa3); partialSM(pB0, pB1, m_reg, mnB, alB);
  __syncthreads(); RESC(alB);
  finishSM(pB0, pB1, alB, l_reg, pa0, pa1, pa2, pa3); SBAR();
  pv_d0(o, vb0 + (int)SHM_V, pa0, pa1, pa2, pa3);
  if (hi == 0) li_l[r32] = l_reg; asm volatile("s_waitcnt lgkmcnt(0)" ::: "memory");
  float rli[16];
#pragma unroll
  for (int r = 0; r < 16; ++r) rli[r] = __builtin_amdgcn_rcpf(li_l[crow(r, hi)]);
  float* Ow = Ob + (long)(wid * QBLK) * LDO;
#pragma unroll
  for (int r = 0; r < 16; ++r) { int orow = crow(r, hi);
    for (int d0 = 0; d0 < 4; ++d0) Ow[(long)orow * LDO + d0 * 32 + r32] = o[d0][r] * rli[r]; }
#undef SLOAD
#undef SWRITE
#undef SWAIT
#undef RESC
}
}

namespace mk {
#define LAS __attribute__((address_space(3)))
typedef unsigned short bf16_t;
typedef short bf16x8 __attribute__((ext_vector_type(8)));
typedef float f32x4 __attribute__((ext_vector_type(4)));
typedef float f32x2 __attribute__((ext_vector_type(2)));
typedef float f32x16 __attribute__((ext_vector_type(16)));
typedef unsigned u32x4 __attribute__((ext_vector_type(4)));
typedef unsigned u32x2 __attribute__((ext_vector_type(2)));
constexpr int M = 16384, DM = 1024, T = 8192, FF = 2816, NIN = 3584, NTH = 512, NWAVES = 8;
constexpr int LDS_BYTES = 131072 + 64;
constexpr float EPS = 1e-6f, LOG2E = 1.4426950408889634f, LN2 = 0.6931471805599453f;
constexpr size_t WS_SSA = 0, WS_SSB = (size_t)1 << 20, WS_DC = (size_t)2 << 20, WS_ASS = (size_t)3 << 20, WS_BAR = ((size_t)3 << 20) + 524288, WS_W = (size_t)4 << 20;
constexpr size_t SZ_W1T = (size_t)2 * FF * DM * 2, SZ_W2T = (size_t)DM * FF * 2, SZ_WIN = (size_t)NIN * DM * 2, SZ_WO = (size_t)DM * DM * 2;
constexpr size_t WS_W1A = WS_W, WS_W2A = WS_W1A + SZ_W1T, WS_WIN = WS_W2A + SZ_W2T, WS_WO = WS_WIN + SZ_WIN, WS_W1B = WS_WO + SZ_WO, WS_W2B = WS_W1B + SZ_W1T;
constexpr size_t WS_X = WS_W2B + SZ_W2T;
constexpr size_t WS_B = WS_X + (size_t)M * DM * 2;
constexpr size_t WS_PR = WS_B + (size_t)M * 1024 * 2;
constexpr size_t WS_C = WS_B + (size_t)M * NIN * 2;
constexpr size_t WS_END = WS_C + (size_t)2048 * 16384 * 2;

__device__ __forceinline__ float bf_lo(unsigned u) { return __uint_as_float(u << 16); }
__device__ __forceinline__ float bf_hi(unsigned u) { return __uint_as_float(u & 0xffff0000u); }
__device__ __forceinline__ unsigned pk(float lo, float hi) { return pg8::cvt_pk_bf16(lo, hi); }
__device__ __forceinline__ float wave_sum(float v) {
#pragma unroll
    for (int o = 1; o < 64; o <<= 1) v += __shfl_xor(v, o);
    return v;
}
__device__ __forceinline__ float fexp(float x) { return __builtin_amdgcn_exp2f(x * LOG2E); }
__device__ __forceinline__ int crow(int r, int hi) { return (r & 3) + 8 * (r >> 2) + 4 * hi; }
#define LDSW() asm volatile("s_waitcnt lgkmcnt(0)" ::: "memory")

#define XB_TMO      128
#define XB_XCNT(j)  (256  + 64 * (j))
#define XB_XSUB(j)  (1280 + 64 * (j))
#define XB_XGEN(j)  (2304 + 64 * (j))
#define XB_TOP      3328
#define XB_TOPGEN   3392
#define XCD_BAR_WORDS 3456
#define XB_SPIN_CAP (1u << 18)

__device__ __forceinline__ unsigned xb_ld(unsigned* p)              { return __hip_atomic_load(p, __ATOMIC_RELAXED, __HIP_MEMORY_SCOPE_AGENT); }
__device__ __forceinline__ unsigned xb_add(unsigned* p, unsigned v) { return __hip_atomic_fetch_add(p, v, __ATOMIC_RELAXED, __HIP_MEMORY_SCOPE_AGENT); }
__device__ __forceinline__ unsigned xb_xcc_id() { return (unsigned)__builtin_amdgcn_s_getreg((3 << 11) | 20) & 0xFu; }
#define XB_SPIN(cond, bar) do { unsigned _sp = 0; while (cond) { __builtin_amdgcn_s_sleep(1); \
    if ((++_sp & 255u) == 0u) { if (xb_ld(&(bar)[XB_TMO])) break; if (_sp > XB_SPIN_CAP) { atomicAdd(&(bar)[XB_TMO], 1u); break; } } } } while (0)

struct XcdBarrier {
    unsigned* bar; unsigned x;
    volatile LAS unsigned* st;
};

__device__ __forceinline__ XcdBarrier xcd_barrier_post(unsigned* bar, volatile LAS unsigned* st) {
    XcdBarrier b; b.bar = bar; b.x = xb_xcc_id(); b.st = st;
    if (threadIdx.x == 0) (void)xb_add(&bar[XB_XCNT(b.x)], 1u);
    return b;
}
__device__ __forceinline__ void xcd_barrier_complete(unsigned* bar, unsigned x, unsigned& nloc, unsigned& nx) {
    const unsigned G = gridDim.x * gridDim.y * gridDim.z;
    unsigned sum, cnt, mine, sp = 0u;
    for (;;) {
        sum = 0u; cnt = 0u; mine = 0u;
#pragma unroll
        for (unsigned j = 0; j < 16; ++j) { const unsigned c = xb_ld(&bar[XB_XCNT(j)]); sum += c; cnt += (c > 0u) ? 1u : 0u; mine = (j == x) ? c : mine; }
        if (sum == G) break;
        __builtin_amdgcn_s_sleep(1);
        if ((++sp & 255u) == 0u) { if (xb_ld(&bar[XB_TMO])) break; if (sp > XB_SPIN_CAP) { atomicAdd(&bar[XB_TMO], 1u); break; } }
    }
    nloc = mine > 0u ? mine : 1u; nx = cnt > 0u ? cnt : 1u;
}

__device__ __forceinline__ void xcd_barrier(const XcdBarrier& b) {
    asm volatile("s_waitcnt vmcnt(0)" ::: "memory");
    __syncthreads();
    if (threadIdx.x == 0) {
        unsigned* bar = b.bar;
        __builtin_amdgcn_s_waitcnt(0);
        unsigned nloc = b.st[0], nx = b.st[1];
        if (nloc == 0u) { xcd_barrier_complete(bar, b.x, nloc, nx); b.st[0] = nloc; b.st[1] = nx; }
        const unsigned old = xb_add(&bar[XB_XSUB(b.x)], 1u);
        const unsigned gen = old / nloc;
        if (old + 1u == (gen + 1u) * nloc) {
            __builtin_amdgcn_fence(__ATOMIC_RELEASE, "agent");
            asm volatile("s_waitcnt vmcnt(0)" ::: "memory");
            const unsigned og = xb_add(&bar[XB_TOP], 1u);
            const unsigned tg = og / nx;
            if (og + 1u == (tg + 1u) * nx) xb_add(&bar[XB_TOPGEN], 1u);
            else XB_SPIN(xb_ld(&bar[XB_TOPGEN]) == tg, bar);
            __builtin_amdgcn_fence(__ATOMIC_ACQUIRE, "agent");
            xb_add(&bar[XB_XGEN(b.x)], 1u);
            asm volatile("s_waitcnt vmcnt(0)" ::: "memory");
        } else {
            XB_SPIN(xb_ld(&bar[XB_XGEN(b.x)]) == gen, bar);
            __builtin_amdgcn_fence(__ATOMIC_ACQUIRE, "agent");
            asm volatile("s_waitcnt vmcnt(0)" ::: "memory");
        }
    }
    __syncthreads();
}

struct Args { const float* in[16]; float* out; unsigned char* ws; int lo, hi; };

__device__ __forceinline__ void tr_item(const float* W, int K, int N, bf16_t* WT, const float* gain, bool swiglu, LAS float* scr, int item, int lane) {
    const int nblk = N / 32, kb = item / nblk, nb = item % nblk, k0 = 64 * kb, n0 = 32 * nb;
    float wv[32];
#pragma unroll
    for (int i = 0; i < 32; ++i) wv[i] = W[(size_t)(k0 + 2 * i + (lane >> 5)) * N + n0 + (lane & 31)];
#pragma unroll
    for (int i = 0; i < 32; ++i) { const int kk = 2 * i + (lane >> 5); float v = wv[i]; if (gain) v *= gain[k0 + kk]; scr[kk * 33 + (lane & 31)] = v; }
    LDSW();
    int dst = n0;
    if (swiglu) { const int half = N / 2; dst = (n0 < half) ? (n0 / 128) * 256 + (n0 % 128) : ((n0 - half) / 128) * 256 + 128 + ((n0 - half) % 128); }
    const int c = lane & 7;
#pragma unroll
    for (int j = 0; j < 4; ++j) { const int n = (lane >> 3) + 8 * j; const LAS float* s = scr + (8 * c) * 33 + n;
        u32x4 o; o.x = pk(s[0 * 33], s[1 * 33]); o.y = pk(s[2 * 33], s[3 * 33]); o.z = pk(s[4 * 33], s[5 * 33]); o.w = pk(s[6 * 33], s[7 * 33]);
        *(u32x4*)(WT + (size_t)(dst + n) * K + k0 + 8 * c) = o; }
    LDSW();
}

__device__ __forceinline__ void rec_gates(const bf16_t* zp  , float lb0, float lb1, float (&g)[8][2], float (&kk)[8][2]) {
#pragma unroll
    for (int i = 0; i < 8; ++i) { const unsigned z = *(const unsigned*)(zp + (size_t)i * 2560);
        const float z0 = bf_lo(z), z1 = bf_hi(z);
        const float s0 = __builtin_amdgcn_rcpf(1.0f + fexp(-z0)), s1 = __builtin_amdgcn_rcpf(1.0f + fexp(-z1));
        const float f0 = lb0 + (1.0f - lb0) * s0, f1 = lb1 + (1.0f - lb1) * s1;
        g[i][0] = __builtin_amdgcn_logf(f0) * LN2; g[i][1] = __builtin_amdgcn_logf(f1) * LN2;
        kk[i][0] = (1.0f - lb0) * (1.0f - s0); kk[i][1] = (1.0f - lb1) * (1.0f - s1); }
}
__device__ __forceinline__ void seg_scan(float (&g)[8][2], int dir, float& t0, float& t1) {
    if (dir == 0) {
#pragma unroll
        for (int i = 1; i < 8; ++i) { g[i][0] += g[i - 1][0]; g[i][1] += g[i - 1][1]; }
        t0 = g[7][0]; t1 = g[7][1];
    } else {
#pragma unroll
        for (int i = 6; i >= 0; --i) { g[i][0] += g[i + 1][0]; g[i][1] += g[i + 1][1]; }
        t0 = g[0][0]; t1 = g[0][1];
    }
}
constexpr int R_VT = 0, R_KT = 18432, R_TS = 55296, R_QT = 63488, R_KT2 = 80896, R_QH = 98304, R_PB = 115712, R_OS = 63488;

__device__ __forceinline__ void lb_pair(const float* lbl, int dir, int ch, float& lb0, float& lb1) {
    const float a0 = lbl[dir * 1024 + ch], a1 = lbl[dir * 1024 + 512 + ch], b0 = lbl[dir * 1024 + ch + 1], b1 = lbl[dir * 1024 + 512 + ch + 1];
    lb0 = 1.0f / (1.0f + expf(a1 - a0)); lb1 = 1.0f / (1.0f + expf(b1 - b0));
}

__device__ __forceinline__ void rec_local(LAS unsigned char* lds, const bf16_t* PR, const float* lbl, bf16_t* LST, float* DC, int item, int tid) {
    const int b = item >> 9, h = (item >> 7) & 3, c = item & 127;
    const int lane = tid & 63, seg = tid >> 6, d0 = 2 * lane, r32 = lane & 31, hi = lane >> 5;
    const size_t row0 = (size_t)b * T + 64 * c + 8 * seg;
    {
        unsigned vv[8];
#pragma unroll
        for (int i = 0; i < 8; ++i) vv[i] = *(const unsigned*)(PR + (row0 + i) * 2560 + 1536 + h * 128 + d0);
        u32x4 lo, hi4;
        lo.x = (vv[0] & 0xffffu) | (vv[1] << 16); lo.y = (vv[2] & 0xffffu) | (vv[3] << 16); lo.z = (vv[4] & 0xffffu) | (vv[5] << 16); lo.w = (vv[6] & 0xffffu) | (vv[7] << 16);
        hi4.x = (vv[0] >> 16) | (vv[1] & 0xffff0000u); hi4.y = (vv[2] >> 16) | (vv[3] & 0xffff0000u); hi4.z = (vv[4] >> 16) | (vv[5] & 0xffff0000u); hi4.w = (vv[6] >> 16) | (vv[7] & 0xffff0000u);
        *(LAS u32x4*)(lds + R_VT + (d0 * 72 + 8 * seg) * 2) = lo; *(LAS u32x4*)(lds + R_VT + ((d0 + 1) * 72 + 8 * seg) * 2) = hi4;
    }
    float g[2][8][2], kk[2][8][2];
#pragma unroll
    for (int dir = 0; dir < 2; ++dir) {
        float lb0, lb1; lb_pair(lbl, dir, h * 128 + d0, lb0, lb1);
        rec_gates(PR + row0 * 2560 + 512 + dir * 512 + h * 128 + d0, lb0, lb1, g[dir], kk[dir]);
        float t0, t1; seg_scan(g[dir], dir, t0, t1);
        *(LAS f32x2*)(lds + R_TS + ((dir * 8 + seg) * 128 + d0) * 4) = (f32x2){t0, t1};
    }
    LDSW(); __syncthreads();
#pragma unroll
    for (int dir = 0; dir < 2; ++dir) {
        float off0 = 0.f, off1 = 0.f, tot0 = 0.f, tot1 = 0.f;
#pragma unroll
        for (int s = 0; s < 8; ++s) { const f32x2 t = *(const LAS f32x2*)(lds + R_TS + ((dir * 8 + s) * 128 + d0) * 4); tot0 += t.x; tot1 += t.y;
            const bool before = dir == 0 ? (s < seg) : (s > seg); if (before) { off0 += t.x; off1 += t.y; } }
        float k0[8], k1[8];
#pragma unroll
        for (int i = 0; i < 8; ++i) { k0[i] = kk[dir][i][0] * fexp(tot0 - (g[dir][i][0] + off0)); k1[i] = kk[dir][i][1] * fexp(tot1 - (g[dir][i][1] + off1)); }
#if defined(RL_TEST) && RL_TEST == 1
#pragma unroll
        for (int i = 0; i < 8; ++i) { k0[i] = 1.0f; k1[i] = 1.0f; }
#endif
        u32x4 w0, w1; w0.x = pk(k0[0], k0[1]); w0.y = pk(k0[2], k0[3]); w0.z = pk(k0[4], k0[5]); w0.w = pk(k0[6], k0[7]);
        w1.x = pk(k1[0], k1[1]); w1.y = pk(k1[2], k1[3]); w1.z = pk(k1[4], k1[5]); w1.w = pk(k1[6], k1[7]);
        *(LAS u32x4*)(lds + R_KT + dir * 18432 + (d0 * 72 + 8 * seg) * 2) = w0; *(LAS u32x4*)(lds + R_KT + dir * 18432 + ((d0 + 1) * 72 + 8 * seg) * 2) = w1;
        if (seg == 0) { const int chain = (b * 4 + h) * 2 + dir; *(f32x2*)(DC + ((size_t)(chain * 128 + c)) * 128 + d0) = (f32x2){fexp(tot0), fexp(tot1)}; }
    }
    LDSW(); __syncthreads();
    {
        const int dir = seg >> 2, mt = seg & 3;
        f32x16 acc[4];
#pragma unroll
        for (int n = 0; n < 4; ++n) acc[n] = (f32x16){};
#pragma unroll
        for (int ks = 0; ks < 4; ++ks) { const bf16x8 a = *(const LAS bf16x8*)(lds + R_VT + ((32 * mt + r32) * 72 + 16 * ks + 8 * hi) * 2);
#pragma unroll
            for (int n = 0; n < 4; ++n) { const bf16x8 bb = *(const LAS bf16x8*)(lds + R_KT + dir * 18432 + ((32 * n + r32) * 72 + 16 * ks + 8 * hi) * 2);
                acc[n] = __builtin_amdgcn_mfma_f32_32x32x16_bf16(a, bb, acc[n], 0, 0, 0); } }
        const int chain = (b * 4 + h) * 2 + dir; bf16_t* L = LST + ((size_t)(chain * 128 + c) << 14);
#pragma unroll
        for (int n = 0; n < 4; ++n)
#pragma unroll
            for (int r = 0; r < 16; ++r) { const int dv = 32 * mt + crow(r, hi), dk = 32 * n + r32; L[dv * 128 + dk] = (bf16_t)(pk(acc[n][r], 0.f) & 0xffffu); }
    }
    __syncthreads();
}

__device__ __forceinline__ void gates_from(const unsigned (&z)[8], float lb0, float lb1, float (&g)[8][2], float (&kk)[8][2]) {
#pragma unroll
    for (int i = 0; i < 8; ++i) { const float z0 = bf_lo(z[i]), z1 = bf_hi(z[i]);
        const float s0 = __builtin_amdgcn_rcpf(1.0f + fexp(-z0)), s1 = __builtin_amdgcn_rcpf(1.0f + fexp(-z1));
        const float f0 = lb0 + (1.0f - lb0) * s0, f1 = lb1 + (1.0f - lb1) * s1;
        g[i][0] = __builtin_amdgcn_logf(f0) * LN2; g[i][1] = __builtin_amdgcn_logf(f1) * LN2;
        kk[i][0] = (1.0f - lb0) * (1.0f - s0); kk[i][1] = (1.0f - lb1) * (1.0f - s1); }
}
__device__ __forceinline__ void rec_out(LAS unsigned char* lds, const bf16_t* PR, const float* lbl, const bf16_t* SP, const float* AO, const float* ASS,
                                        const float* attn_gain, const float* rec_gain, bf16_t* MIX, int item, int h, float& ra, int tid) {
    const int b = item >> 7, c = item & 127;
    const int lane = tid & 63, seg = tid >> 6, d0 = 2 * lane, r32 = lane & 31, hi = lane >> 5;
    const size_t rowc = (size_t)b * T + 64 * c, row0 = rowc + 8 * seg;
    const int mt = seg >> 2, nt = seg & 3;
    const int bt = (seg >> 1) & 1, bs = seg & 1;
    const int erow = tid >> 3, sg = tid & 7; const size_t grow = rowc + erow;
    unsigned vv[8], qq[8], zz[2][8];
#pragma unroll
    for (int i = 0; i < 8; ++i) { const bf16_t* rp = PR + (row0 + i) * 2560 + h * 128 + d0;
        qq[i] = *(const unsigned*)rp; zz[0][i] = *(const unsigned*)(rp + 512); zz[1][i] = *(const unsigned*)(rp + 1024); vv[i] = *(const unsigned*)(rp + 1536); }
    if (h == 0) { float sa = 0.f;
#pragma unroll 4
        for (int j = 0; j < 16; ++j) { const f32x4 t4 = *(const f32x4*)(AO + grow * 512 + 64 * sg + 4 * j); sa += (t4[0] * t4[0] + t4[1] * t4[1]) + (t4[2] * t4[2] + t4[3] * t4[3]); }
        sa += __shfl_xor(sa, 1); sa += __shfl_xor(sa, 2); sa += __shfl_xor(sa, 4);
        ra = 1.0f / sqrtf(sa * (1.0f / 512.0f) + EPS); }
    {
        u32x4 lo, hi4;
        lo.x = (vv[0] & 0xffffu) | (vv[1] << 16); lo.y = (vv[2] & 0xffffu) | (vv[3] << 16); lo.z = (vv[4] & 0xffffu) | (vv[5] << 16); lo.w = (vv[6] & 0xffffu) | (vv[7] << 16);
        hi4.x = (vv[0] >> 16) | (vv[1] & 0xffff0000u); hi4.y = (vv[2] >> 16) | (vv[3] & 0xffff0000u); hi4.z = (vv[4] >> 16) | (vv[5] & 0xffff0000u); hi4.w = (vv[6] >> 16) | (vv[7] & 0xffff0000u);
        *(LAS u32x4*)(lds + R_VT + (d0 * 72 + 8 * seg) * 2) = lo; *(LAS u32x4*)(lds + R_VT + ((d0 + 1) * 72 + 8 * seg) * 2) = hi4;
    }
    f32x16 oacc = (f32x16){}, pacc = (f32x16){};
#pragma unroll
    for (int dir = 0; dir < 2; ++dir) {
        asm volatile("" ::: "memory");
        bf16x8 sb[8];
        { const int chain = (b * 4 + h) * 2 + dir; const bf16_t* S = SP + ((size_t)(chain * 128 + c) << 14) + (size_t)(32 * nt + r32) * 128 + 8 * hi;
#pragma unroll
            for (int ks = 0; ks < 8; ++ks) sb[ks] = *(const bf16x8*)(S + 16 * ks); }
        float g[8][2], kk[8][2];
        float lb0, lb1; lb_pair(lbl, dir, h * 128 + d0, lb0, lb1);
        gates_from(zz[dir], lb0, lb1, g, kk);
        float t0, t1; seg_scan(g, dir, t0, t1);
        *(LAS f32x2*)(lds + R_TS + (seg * 128 + d0) * 4) = (f32x2){t0, t1};
        LDSW(); __syncthreads();
        float off0 = 0.f, off1 = 0.f, ref0 = 0.f, ref1 = 0.f;
#pragma unroll
        for (int s = 0; s < 8; ++s) { const f32x2 t = *(const LAS f32x2*)(lds + R_TS + (s * 128 + d0) * 4);
            const bool before = dir == 0 ? (s < seg) : (s > seg); if (before) { off0 += t.x; off1 += t.y; }
            const bool inref = dir == 0 ? (s < 4) : (s >= 4); if (inref) { ref0 += t.x; ref1 += t.y; } }
#pragma unroll
        for (int i = 0; i < 8; ++i) {
            const float q0 = bf_lo(qq[i]), q1 = bf_hi(qq[i]);
            const float b0 = g[i][0] + off0, b1 = g[i][1] + off1;
            const float eq0 = fexp(b0 - ref0), eq1 = fexp(b1 - ref1), ek0 = fexp(ref0 - b0), ek1 = fexp(ref1 - b1), eh0 = fexp(b0), eh1 = fexp(b1);
            const int ro = ((8 * seg + i) * 136 + d0) * 2;
            *(LAS unsigned*)(lds + R_QT + ro) = pk(q0 * eq0, q1 * eq1);
            *(LAS unsigned*)(lds + R_KT2 + ro) = pk(kk[i][0] * ek0, kk[i][1] * ek1);
            *(LAS unsigned*)(lds + R_QH + ro) = pk(q0 * eh0, q1 * eh1);
        }
        LDSW(); __syncthreads();
        if (seg < 4 && !((dir == 0 && bt == 0 && bs == 1) || (dir == 1 && bt == 1 && bs == 0))) {
            f32x16 sc = (f32x16){};
#pragma unroll
            for (int ks = 0; ks < 8; ++ks) {
                const bf16x8 a = *(const LAS bf16x8*)(lds + R_QT + ((32 * bt + r32) * 136 + 16 * ks + 8 * hi) * 2);
                const bf16x8 bb = *(const LAS bf16x8*)(lds + R_KT2 + ((32 * bs + r32) * 136 + 16 * ks + 8 * hi) * 2);
                sc = __builtin_amdgcn_mfma_f32_32x32x16_bf16(a, bb, sc, 0, 0, 0); }
#pragma unroll
            for (int r = 0; r < 16; ++r) { const int t = 32 * bt + crow(r, hi), s = 32 * bs + r32; const bool keep = dir == 0 ? (s <= t) : (s >= t); pacc[r] += keep ? sc[r] : 0.f; }
        }
#pragma unroll
        for (int ks = 0; ks < 8; ++ks) { const bf16x8 a = *(const LAS bf16x8*)(lds + R_QH + ((32 * mt + r32) * 136 + 16 * ks + 8 * hi) * 2);
            oacc = __builtin_amdgcn_mfma_f32_32x32x16_bf16(a, sb[ks], oacc, 0, 0, 0); }
        LDSW(); __syncthreads();
    }
    asm volatile("" ::: "memory");
    const u32x4 gz0 = *(const u32x4*)(PR + grow * 2560 + 2048 + h * 128 + 16 * sg), gz1 = *(const u32x4*)(PR + grow * 2560 + 2048 + h * 128 + 16 * sg + 8);
    f32x4 a4[4];
#pragma unroll
    for (int j = 0; j < 4; ++j) a4[j] = *(const f32x4*)(AO + grow * 512 + h * 128 + 16 * sg + 4 * j);
    if (seg < 4) {
#pragma unroll
        for (int r = 0; r < 16; ++r) { const int t = 32 * bt + crow(r, hi), s = 32 * bs + r32; *(LAS bf16_t*)(lds + R_PB + (t * 72 + s) * 2) = (bf16_t)(pk(pacc[r], 0.f) & 0xffffu); }
    }
    LDSW(); __syncthreads();
#pragma unroll
    for (int ks = 0; ks < 4; ++ks) { const bf16x8 a = *(const LAS bf16x8*)(lds + R_PB + ((32 * mt + r32) * 72 + 16 * ks + 8 * hi) * 2);
        const bf16x8 bb = *(const LAS bf16x8*)(lds + R_VT + ((32 * nt + r32) * 72 + 16 * ks + 8 * hi) * 2);
        oacc = __builtin_amdgcn_mfma_f32_32x32x16_bf16(a, bb, oacc, 0, 0, 0); }
#pragma unroll
    for (int r = 0; r < 16; ++r) *(LAS float*)(lds + R_OS + ((32 * mt + crow(r, hi)) * 132 + 32 * nt + r32) * 4) = oacc[r];
    LDSW(); __syncthreads();
    {
        f32x4 o4[4]; float ss = 0.f;
#pragma unroll
        for (int j = 0; j < 4; ++j) { o4[j] = *(const LAS f32x4*)(lds + R_OS + (erow * 132 + 16 * sg + 4 * j) * 4); ss += (o4[j][0] * o4[j][0] + o4[j][1] * o4[j][1]) + (o4[j][2] * o4[j][2] + o4[j][3] * o4[j][3]); }
        ss += __shfl_xor(ss, 1); ss += __shfl_xor(ss, 2); ss += __shfl_xor(ss, 4);
        const float rstd = 1.0f / sqrtf(ss * (1.0f / 128.0f) + EPS);
        const unsigned gz[8] = {gz0.x, gz0.y, gz0.z, gz0.w, gz1.x, gz1.y, gz1.z, gz1.w};
        float res[16];
#pragma unroll
        for (int e = 0; e < 16; ++e) { const float gt = (e & 1) ? bf_hi(gz[e >> 1]) : bf_lo(gz[e >> 1]); res[e] = o4[e >> 2][e & 3] * rstd * rec_gain[16 * sg + e] * pg8::silu_f(gt); }
        u32x4 w0, w1; w0.x = pk(res[0], res[1]); w0.y = pk(res[2], res[3]); w0.z = pk(res[4], res[5]); w0.w = pk(res[6], res[7]);
        w1.x = pk(res[8], res[9]); w1.y = pk(res[10], res[11]); w1.z = pk(res[12], res[13]); w1.w = pk(res[14], res[15]);
        *(u32x4*)(MIX + grow * 1024 + 512 + h * 128 + 16 * sg) = w0; *(u32x4*)(MIX + grow * 1024 + 512 + h * 128 + 16 * sg + 8) = w1;
        float av[16];
#pragma unroll
        for (int j = 0; j < 4; ++j) { const f32x4 g4 = *(const f32x4*)(attn_gain + h * 128 + 16 * sg + 4 * j);
            av[4 * j + 0] = a4[j][0] * ra * g4[0]; av[4 * j + 1] = a4[j][1] * ra * g4[1]; av[4 * j + 2] = a4[j][2] * ra * g4[2]; av[4 * j + 3] = a4[j][3] * ra * g4[3]; }
        w0.x = pk(av[0], av[1]); w0.y = pk(av[2], av[3]); w0.z = pk(av[4], av[5]); w0.w = pk(av[6], av[7]);
        w1.x = pk(av[8], av[9]); w1.y = pk(av[10], av[11]); w1.z = pk(av[12], av[13]); w1.w = pk(av[14], av[15]);
        *(u32x4*)(MIX + grow * 1024 + h * 128 + 16 * sg) = w0; *(u32x4*)(MIX + grow * 1024 + h * 128 + 16 * sg + 8) = w1;
    }
    __syncthreads();
}

__device__ __forceinline__ void qk_norm_rope(bf16_t* PA, const float* qg, const float* kg, int gw, int ngw, int lane) {
    const int a = lane & 15, half = a >> 3, j0 = (a & 3) * 8; const bool isx2 = (a & 4) != 0;
    float invf[8];
#pragma unroll
    for (int e = 0; e < 8; ++e) invf[e] = __builtin_amdgcn_exp2f(-(float)(j0 + e) * 0.41524101186092029f) * 0.15915494309189535f;
    for (int gi = gw; gi < M * 6 / 4; gi += 2 * ngw) {
        bf16_t* pp[2]; u32x4 rawv[2]; int rows[2], hvs[2];
#pragma unroll
        for (int q2 = 0; q2 < 2; ++q2) { const int g2 = gi + q2 * ngw; const int vid = g2 * 4 + (lane >> 4); rows[q2] = vid / 6; hvs[q2] = vid - rows[q2] * 6;
            pp[q2] = PA + (size_t)rows[q2] * 1024 + hvs[q2] * 128 + 8 * a; rawv[q2] = (g2 < M * 6 / 4) ? *(const u32x4*)pp[q2] : (u32x4){0u, 0u, 0u, 0u}; }
#pragma unroll
        for (int q2 = 0; q2 < 2; ++q2) {
            const int row = rows[q2], hv = hvs[q2]; const u32x4 raw = rawv[q2]; const unsigned rw[4] = {raw.x, raw.y, raw.z, raw.w};
            float x[8]; float ss = 0.f;
#pragma unroll
            for (int e = 0; e < 4; ++e) { x[2 * e] = bf_lo(rw[e]); x[2 * e + 1] = bf_hi(rw[e]); ss += x[2 * e] * x[2 * e] + x[2 * e + 1] * x[2 * e + 1]; }
            ss += __shfl_xor(ss, 1); ss += __shfl_xor(ss, 2); ss += __shfl_xor(ss, 4); ss += __shfl_xor(ss, 8);
            const float rstd = 1.0f / sqrtf(ss * (1.0f / 128.0f) + EPS);
            const float* gn = (hv < 4 ? qg : kg) + 8 * a;
            float y[8], yp[8];
#pragma unroll
            for (int e = 0; e < 8; ++e) y[e] = x[e] * rstd * gn[e];
#pragma unroll
            for (int e = 0; e < 8; ++e) yp[e] = __shfl_xor(y[e], 4);
            const int t = row & (T - 1); const float id = (float)(half ? (t & 63) : (t >> 6));
            float o[8];
#pragma unroll
            for (int e = 0; e < 8; ++e) { const float rev = id * invf[e], fr = rev - floorf(rev); const float cs = __builtin_amdgcn_cosf(fr), sn = __builtin_amdgcn_sinf(fr);
                o[e] = isx2 ? (y[e] * cs + yp[e] * sn) : (y[e] * cs - yp[e] * sn); }
            u32x4 w; w.x = pk(o[0], o[1]); w.y = pk(o[2], o[3]); w.z = pk(o[4], o[5]); w.w = pk(o[6], o[7]);
            if (gi + q2 * ngw < M * 6 / 4) *(u32x4*)pp[q2] = w;
        }
    }
}

__global__ void __launch_bounds__(NTH, 2) hybrid_fwd(Args args) {
    extern __shared__ __attribute__((aligned(16))) unsigned char lds_raw[];
    LAS unsigned char* lds = (LAS unsigned char*)lds_raw;
    const int tid = threadIdx.x, lane = tid & 63, wave = __builtin_amdgcn_readfirstlane(tid >> 6);
    const int G = gridDim.x, gw = blockIdx.x * NWAVES + wave, NGW = G * NWAVES;
    unsigned char* ws = args.ws;
    const float* x = args.in[0];
    float* out = args.out;
    float* SSA = (float*)(ws + WS_SSA); float* SSB = (float*)(ws + WS_SSB); float* DC = (float*)(ws + WS_DC); float* ASS = (float*)(ws + WS_ASS);
    bf16_t* W1A = (bf16_t*)(ws + WS_W1A); bf16_t* W2A = (bf16_t*)(ws + WS_W2A); bf16_t* WIN = (bf16_t*)(ws + WS_WIN); bf16_t* WO = (bf16_t*)(ws + WS_WO);
    bf16_t* W1B = (bf16_t*)(ws + WS_W1B); bf16_t* W2B = (bf16_t*)(ws + WS_W2B);
    bf16_t* XB = (bf16_t*)(ws + WS_X); float* AO = (float*)(ws + WS_X); bf16_t* X2B = (bf16_t*)(ws + WS_X);
    bf16_t* H = (bf16_t*)(ws + WS_B); bf16_t* PA = (bf16_t*)(ws + WS_B); bf16_t* PR = (bf16_t*)(ws + WS_PR); bf16_t* MIX = (bf16_t*)(ws + WS_B);
    bf16_t* LST = (bf16_t*)(ws + WS_C);
    bf16_t* X1S = (bf16_t*)out;
    const int lo = args.lo, hi = args.hi;
    volatile LAS unsigned* bst = (volatile LAS unsigned*)(lds + 131072);
    if (tid < 2) bst[tid] = 0u;
    __syncthreads();
    const XcdBarrier bar = xcd_barrier_post((unsigned*)(ws + WS_BAR), bst);
#ifdef PH_ONLY
#define IN(k) ((k) == PH_ONLY && lo <= (k) && (k) < hi)
#else
#define IN(k) (lo <= (k) && (k) < hi)
#endif
#ifdef TS_LO
    unsigned long long ts_t0 = 0, ts_t1 = 0;
#define TS_A(k) do { if ((k) == TS_LO) ts_t0 = __builtin_amdgcn_s_memrealtime(); } while (0)
#define TS_B(k) do { if ((k) == TS_HI) ts_t1 = __builtin_amdgcn_s_memrealtime(); } while (0)
#else
#define TS_A(k) do {} while (0)
#define TS_B(k) do {} while (0)
#endif
#define SEAM(k) do { if (IN(k) && IN((k) + 1)) { if (lo > 1000) cg::this_grid().sync();   xcd_barrier(bar); } TS_B(k); TS_A((k) + 1); } while (0)

    TS_A(0);
    if (IN(0)) {
        LAS float* scr = (LAS float*)(lds + wave * 8448);
        constexpr int I1 = (DM / 64) * (2 * FF / 32), I2 = (FF / 64) * (DM / 32), I3 = (DM / 64) * (NIN / 32), I4 = (DM / 64) * (DM / 32);
        constexpr int NITEMS = 2 * I1 + 2 * I2 + I3 + I4;
        for (int it = gw; it < NITEMS; it += NGW) {
            int r = it;
            if (r < I1) { tr_item(args.in[2], DM, 2 * FF, W1A, args.in[1], true, scr, r, lane); continue; } r -= I1;
            if (r < I2) { tr_item(args.in[3], FF, DM, W2A, nullptr, false, scr, r, lane); continue; } r -= I2;
            if (r < I3) { tr_item(args.in[5], DM, NIN, WIN, args.in[4], false, scr, r, lane); continue; } r -= I3;
            if (r < I4) { tr_item(args.in[11], DM, DM, WO, nullptr, false, scr, r, lane); continue; } r -= I4;
            if (r < I1) { tr_item(args.in[13], DM, 2 * FF, W1B, args.in[12], true, scr, r, lane); continue; } r -= I1;
            tr_item(args.in[14], FF, DM, W2B, nullptr, false, scr, r, lane);
        }
        for (int m0 = gw; m0 < M; m0 += 2 * NGW) {
            f32x4 v[2][4]; float sq[2];
#pragma unroll
            for (int q2 = 0; q2 < 2; ++q2) { const int m = m0 + q2 * NGW < M ? m0 + q2 * NGW : m0; const f32x4* xr = (const f32x4*)(x + (size_t)m * DM) + lane;
#pragma unroll
                for (int j = 0; j < 4; ++j) v[q2][j] = xr[64 * j]; }
#pragma unroll
            for (int q2 = 0; q2 < 2; ++q2) { float s = 0.f;
#pragma unroll
                for (int j = 0; j < 4; ++j) s += (v[q2][j][0] * v[q2][j][0] + v[q2][j][1] * v[q2][j][1]) + (v[q2][j][2] * v[q2][j][2] + v[q2][j][3] * v[q2][j][3]);
                sq[q2] = wave_sum(s); }
#pragma unroll
            for (int q2 = 0; q2 < 2; ++q2) { const int m = m0 + q2 * NGW; if (m < M) { u32x2* o8 = (u32x2*)(XB + (size_t)m * DM) + lane;
#pragma unroll
                for (int j = 0; j < 4; ++j) o8[64 * j] = (u32x2){pk(v[q2][j][0], v[q2][j][1]), pk(v[q2][j][2], v[q2][j][3])};
                if (lane < 16) SSA[(size_t)m * 16 + lane] = lane == 0 ? sq[q2] : 0.f; } }
        }
        __syncthreads();
    }
    SEAM(0);
    if (IN(1)) { pg8::Gemm g{XB, W1A, M, 2 * FF, DM}; pg8::StaticOrder S; S.init(M, 2 * FF, G, (int)blockIdx.x); pg8::EpiSwiGLU E{H, FF, SSA};
        pg8::gemm_phase<pg8::EpiSwiGLU, pg8::StaticOrder, true, true>(lds, g, S, E); }
    SEAM(1);
    if (IN(2)) { pg8::Gemm g{H, W2A, M, DM, FF}; pg8::StaticOrder S; S.init(M, DM, G, (int)blockIdx.x); pg8::EpiResid<false, false> E{x, X1S, SSB, 0.5f};
        pg8::gemm_phase<pg8::EpiResid<false, false>, pg8::StaticOrder, true, true>(lds, g, S, E); }
    SEAM(2);
    if (IN(3)) { pg8::Gemm g{X1S, WIN, M, NIN, DM}; pg8::StaticOrder S; S.init(M, NIN, G, (int)blockIdx.x); pg8::EpiProj E{PA, PR, SSB};
        pg8::gemm_phase<pg8::EpiProj, pg8::StaticOrder, true, true>(lds, g, S, E); }
    SEAM(3);
    if (IN(4)) {
        qk_norm_rope(PA, args.in[6], args.in[7], gw, NGW, lane);
        for (int it = blockIdx.x; it < 1024; it += G) rec_local(lds, PR, args.in[9], LST, DC, it, tid);
    }
    SEAM(4);
    if (IN(5)) {
#ifndef X_NOSCAN
        for (int p = blockIdx.x * NTH + tid; p < 16 * 8192; p += G * NTH) {
            const int chain = p >> 13, pair = p & 8191, dk0 = (pair & 63) * 2, dir = chain & 1;
            float s0 = 0.f, s1 = 0.f;
#pragma unroll 16
            for (int st = 0; st < 128; ++st) { const int c = dir ? 127 - st : st;
                unsigned* ptr = (unsigned*)(LST + ((size_t)(chain * 128 + c) << 14)) + pair;
                const unsigned l = *ptr; const f32x2 dc = *(const f32x2*)(DC + (size_t)(chain * 128 + c) * 128 + dk0);
                *ptr = pk(s0, s1);
                s0 = dc.x * s0 + bf_lo(l); s1 = dc.y * s1 + bf_hi(l); }
        }
#endif
#ifdef X_NOLOOP
        { const int u = blockIdx.x;
#else
        for (int u = blockIdx.x; u < 256; u += G) {
#endif
            const int xcd = u & 7, j = u >> 3, pair = xcd >> 1, b = pair >> 1, kvh = pair & 1, h = 2 * kvh + (xcd & 1);
            const size_t r0 = (size_t)b * T + 256 * j;
            att::attn_dense_body<att::bf16>((const att::bf16*)(PA + r0 * 1024 + h * 128), (const att::bf16*)(PA + (size_t)b * T * 1024 + 512 + kvh * 128),
                                            (const att::bf16*)(PA + (size_t)b * T * 1024 + 768 + kvh * 128), AO + r0 * 512 + h * 128, T, (char*)lds_raw);
            __syncthreads();
        }
    }
    SEAM(5);
    if (IN(6)) { for (int it = blockIdx.x; it < 256; it += G) { float ra = 0.f;
#pragma unroll 1
        for (int h = 0; h < 4; ++h) rec_out(lds, PR, args.in[9], LST, AO, ASS, args.in[8], args.in[10], MIX, it, h, ra, tid); } }
    SEAM(6);
    if (IN(7)) { pg8::Gemm g{MIX, WO, M, DM, DM}; pg8::StaticOrder S; S.init(M, DM, G, (int)blockIdx.x); pg8::EpiResid<true, false> E{X1S, X2B, SSA, 1.0f};
        pg8::gemm_phase<pg8::EpiResid<true, false>, pg8::StaticOrder, true, true>(lds, g, S, E); }
    SEAM(7);
    if (IN(8)) { pg8::Gemm g{X2B, W1B, M, 2 * FF, DM}; pg8::StaticOrder S; S.init(M, 2 * FF, G, (int)blockIdx.x); pg8::EpiSwiGLU E{H, FF, SSA};
        pg8::gemm_phase<pg8::EpiSwiGLU, pg8::StaticOrder, true, true>(lds, g, S, E); }
    SEAM(8);
    if (IN(9)) { pg8::Gemm g{H, W2B, M, DM, FF}; pg8::StaticOrder S; S.init(M, DM, G, (int)blockIdx.x); pg8::EpiResid<true, true> E{X2B, out, nullptr, 0.5f};
        pg8::gemm_phase<pg8::EpiResid<true, true>, pg8::StaticOrder, true, true>(lds, g, S, E); }
    SEAM(9);
    if (IN(10)) {
        const float* fg = args.in[15];
        for (int m = gw; m < M; m += NGW) {
            f32x4* xr = (f32x4*)(out + (size_t)m * DM) + lane; f32x4 v[4]; float s = 0.f;
#pragma unroll
            for (int j = 0; j < 4; ++j) { v[j] = xr[64 * j]; s += (v[j][0] * v[j][0] + v[j][1] * v[j][1]) + (v[j][2] * v[j][2] + v[j][3] * v[j][3]); }
            const float rstd = 1.0f / sqrtf(wave_sum(s) * (1.0f / DM) + EPS);
#pragma unroll
            for (int j = 0; j < 4; ++j) { const f32x4 gn = *((const f32x4*)fg + lane + 64 * j); xr[64 * j] = v[j] * rstd * gn; }
        }
    }
#ifdef TS_LO
    TS_B(10);
    cg::this_grid().sync();
    if (blockIdx.x == 0) { const unsigned K = (unsigned)(ts_t1 - ts_t0); for (unsigned i = tid; i < K && i < 300000u; i += NTH) out[i] += 0.1f; }
#endif
#undef IN
#undef SEAM
}
}

#ifdef DBG
__global__ void dbg_dump_bf16(const unsigned short* src, float* out, size_t n) { for (size_t i = blockIdx.x * (size_t)blockDim.x + threadIdx.x; i < n; i += (size_t)gridDim.x * blockDim.x) out[i] = __uint_as_float((unsigned)src[i] << 16); }
__global__ void dbg_dump_f32(const float* src, float* out, size_t n) { for (size_t i = blockIdx.x * (size_t)blockDim.x + threadIdx.x; i < n; i += (size_t)gridDim.x * blockDim.x) out[i] = src[i]; }
#endif
extern "C" void kernel_launch(void* const* d_in, const int* in_sizes, int n_in, void* d_out, int out_size, void* d_ws, size_t ws_size, hipStream_t stream) {
    using namespace mk;
    static int grid = 0;
    if (grid == 0) {
        if (n_in != 16 || in_sizes[0] != M * DM || out_size != M * DM || ws_size < WS_END) {
            fprintf(stderr, "kernel_launch: built for 16 inputs, x/out of %d floats, >= %zu bytes of workspace; got n_in %d in0 %d out %d ws %zu\n", M * DM, (size_t)WS_END, n_in, n_in > 0 ? in_sizes[0] : -1, out_size, ws_size);
            grid = -1; return; }
        int dev = 0, cus = 0, per_cu = 0;
        hipGetDevice(&dev); hipDeviceGetAttribute(&cus, hipDeviceAttributeMultiprocessorCount, dev);
        if (hipFuncSetAttribute((const void*)hybrid_fwd, hipFuncAttributeMaxDynamicSharedMemorySize, LDS_BYTES) != hipSuccess) { fprintf(stderr, "kernel_launch: hipFuncSetAttribute failed\n"); grid = -1; return; }
        if (hipOccupancyMaxActiveBlocksPerMultiprocessor(&per_cu, (const void*)hybrid_fwd, NTH, LDS_BYTES) != hipSuccess || per_cu < 1) { fprintf(stderr, "kernel_launch: occupancy query says %d\n", per_cu); per_cu = 1; }
        (void)hipGetLastError();
        grid = cus * per_cu; if (grid > 256) grid = 256;
    }
    if (grid < 0) return;
    if (hipMemsetAsync((char*)d_ws + WS_BAR, 0, XCD_BAR_WORDS * 4, stream) != hipSuccess) { fprintf(stderr, "kernel_launch: memset of the barrier words failed\n"); return; }
    Args a{};
    for (int i = 0; i < 16; ++i) a.in[i] = (const float*)d_in[i];
    a.out = (float*)d_out; a.ws = (unsigned char*)d_ws;
#if MK_LAUNCHES == 1
    a.lo = 0; a.hi = 11;
    void* kargs[] = {&a};
    hipError_t e = hipLaunchCooperativeKernel((const void*)hybrid_fwd, dim3(grid), dim3(NTH), kargs, LDS_BYTES, stream);
    if (e != hipSuccess) fprintf(stderr, "kernel_launch: cooperative launch failed: %s (grid %d)\n", hipGetErrorString(e), grid);
#else
#ifdef DBG
    const int last = DBG == 7 ? 3 : DBG == 6 ? 6 : DBG == 5 ? 5 : DBG == 4 ? 4 : DBG == 3 ? 3 : DBG == 1 ? 1 : 2;
    for (int ph = 0; ph <= last; ++ph) { a.lo = ph; a.hi = ph + 1; hipLaunchKernelGGL(hybrid_fwd, dim3(grid), dim3(NTH), LDS_BYTES, stream, a); }
    const size_t n = (size_t)M * DM; unsigned char* w = (unsigned char*)d_ws;
    if (DBG == 6) hipLaunchKernelGGL(dbg_dump_bf16, dim3(1024), dim3(256), 0, stream, (const unsigned short*)(w + WS_B), (float*)d_out, n);
    if (DBG == 5) hipLaunchKernelGGL(dbg_dump_f32, dim3(1024), dim3(256), 0, stream, (const float*)(w + WS_X), (float*)d_out, n / 2);
    if (DBG == 4) hipLaunchKernelGGL(dbg_dump_bf16, dim3(1024), dim3(256), 0, stream, (const unsigned short*)(w + WS_C), (float*)d_out, n);
    if (DBG == 3) hipLaunchKernelGGL(dbg_dump_bf16, dim3(1024), dim3(256), 0, stream, (const unsigned short*)(w + WS_B), (float*)d_out, n);
    if (DBG == 7) hipLaunchKernelGGL(dbg_dump_bf16, dim3(1024), dim3(256), 0, stream, (const unsigned short*)(w + WS_PR), (float*)d_out, n);
    if (DBG == 1) hipLaunchKernelGGL(dbg_dump_bf16, dim3(1024), dim3(256), 0, stream, (const unsigned short*)(w + WS_B), (float*)d_out, n);
#else
    for (int ph = 0; ph < 11; ++ph) { a.lo = ph; a.hi = ph + 1; hipLaunchKernelGGL(hybrid_fwd, dim3(grid), dim3(NTH), LDS_BYTES, stream, a); }
#endif
#endif
}
```
